# Optimizing an MI355X kernel written in HIP

```python
import jax, jax.numpy as jnp
from jax import lax
import numpy as np

D_MODEL = 1024
BATCH = 8
SEQ = 4096
DEPTH = 1

N_MEM = 256
SC_WIDTH = D_MODEL
SC_KERNEL = 3
CF_WIDTH = D_MODEL
CF_KERNEL = 31
XA_HEADS = 4
XA_HEAD_DIM = D_MODEL // XA_HEADS
PEER_HEADS = 8
PEER_NKEYS = 128
PEER_TOPK = 16
PEER_QDIM = 256
PEER_HALF = PEER_QDIM // 2
PEER_EXPERTS = PEER_NKEYS * PEER_NKEYS
PEER_CHUNK = 128
IN_COLS = 3 * SC_WIDTH + 2 * CF_WIDTH + 2 * D_MODEL
EPS = 1e-6

kernel_name = 'hybrid_conv_memattn_peer_block'


def rms_norm(x, g):
    xf = x.astype(jnp.float32)
    y = xf * lax.rsqrt(jnp.mean(xf * xf, axis=-1, keepdims=True) + EPS)
    return (y * g.astype(jnp.float32)).astype(x.dtype)


def layer_norm(x, g, b):
    xf = x.astype(jnp.float32)
    mu = jnp.mean(xf, axis=-1, keepdims=True)
    var = jnp.mean(jnp.square(xf - mu), axis=-1, keepdims=True)
    y = (xf - mu) * lax.rsqrt(var + EPS)
    return (y * g.astype(jnp.float32) + b.astype(jnp.float32)).astype(x.dtype)


def causal_depthwise_conv(x, w):
    k, c = w.shape
    return lax.conv_general_dilated(
        x, w.reshape(k, 1, c).astype(x.dtype), window_strides=(1,), padding=[(k - 1, 0)],
        dimension_numbers=('NWC', 'WIO', 'NWC'), feature_group_count=c)


def conv_mixers(h, w_in, cf_b_pw1, sc_conv_w, sc_w_out, cf_conv_w, cf_conv_b, cf_ln_g, cf_ln_b,
                cf_w_pw2, cf_b_pw2, w_mix_out):
    proj = jnp.einsum('bsd,dc->bsc', h, w_in)
    cuts = [SC_WIDTH, 2 * SC_WIDTH, 3 * SC_WIDTH, 3 * SC_WIDTH + CF_WIDTH,
            3 * SC_WIDTH + 2 * CF_WIDTH, 3 * SC_WIDTH + 2 * CF_WIDTH + D_MODEL]
    sc_b, sc_c, sc_x, cf_a, cf_g, gate_sc, gate_cf = jnp.split(proj, cuts, axis=-1)
    y_sc = sc_b * causal_depthwise_conv(sc_c * sc_x, sc_conv_w)
    y_sc = jnp.einsum('bsc,cd->bsd', y_sc, sc_w_out)
    cf = (cf_a + cf_b_pw1[:CF_WIDTH]) * jax.nn.sigmoid(cf_g + cf_b_pw1[CF_WIDTH:])
    cf = causal_depthwise_conv(cf, cf_conv_w) + cf_conv_b
    cf = jax.nn.silu(layer_norm(cf, cf_ln_g, cf_ln_b))
    y_cf = jnp.einsum('bsc,cd->bsd', cf, cf_w_pw2) + cf_b_pw2
    merged = jax.nn.sigmoid(gate_sc) * y_sc + jax.nn.sigmoid(gate_cf) * y_cf
    return jnp.einsum('bsd,de->bse', merged, w_mix_out)


def memory_cross_attention(h, mem_n, w_q, w_kv, w_xo):
    b, s, _ = h.shape
    m = mem_n.shape[1]
    q = jnp.einsum('bsd,de->bse', h, w_q).reshape(b, s, XA_HEADS, XA_HEAD_DIM)
    kv = jnp.einsum('bmd,de->bme', mem_n, w_kv).reshape(b, m, 2, XA_HEADS, XA_HEAD_DIM)
    k, v = kv[:, :, 0], kv[:, :, 1]
    scores = jnp.einsum('bshd,bmhd->bhsm', q, k).astype(jnp.float32) * (XA_HEAD_DIM ** -0.5)
    probs = jax.nn.softmax(scores, axis=-1).astype(v.dtype)
    o = jnp.einsum('bhsm,bmhd->bshd', probs, v).reshape(b, s, XA_HEADS * XA_HEAD_DIM)
    return jnp.einsum('bse,ed->bsd', o, w_xo)


def peer_ffn(h, w_pq, subkeys, u, v):
    b, s, d = h.shape
    q = jnp.einsum('bsd,dq->bsq', h, w_pq).reshape(b, s, PEER_HEADS, 2, PEER_HALF)
    sub_scores = jnp.einsum('bshpc,pnc->bshpn', q, subkeys).astype(jnp.float32)
    top_s, top_i = lax.top_k(sub_scores, PEER_TOPK)
    n_cand = PEER_TOPK * PEER_TOPK
    cand_s = (top_s[..., 0, :, None] + top_s[..., 1, None, :]).reshape(b, s, PEER_HEADS, n_cand)
    cand_i = (top_i[..., 0, :, None] * PEER_NKEYS + top_i[..., 1, None, :]).reshape(b, s, PEER_HEADS, n_cand)
    fin_s, fin_pos = lax.top_k(cand_s, PEER_TOPK)
    expert_idx = jnp.take_along_axis(cand_i, fin_pos, axis=-1)
    gates = jax.nn.softmax(fin_s, axis=-1).astype(h.dtype)
    n_chunks = (b * s) // PEER_CHUNK
    h_c = h.reshape(n_chunks, PEER_CHUNK, d)
    e_c = expert_idx.reshape(n_chunks, PEER_CHUNK, PEER_HEADS, PEER_TOPK)
    g_c = gates.reshape(n_chunks, PEER_CHUNK, PEER_HEADS, PEER_TOPK)

    def chunk(args):
        hc, ec, gc = args
        u_sel = jnp.take(u, ec, axis=0)
        act = jax.nn.gelu(jnp.einsum('chkd,cd->chk', u_sel, hc), approximate=False) * gc
        v_sel = jnp.take(v, ec, axis=0)
        return jnp.einsum('chk,chkd->cd', act, v_sel)

    out = lax.map(chunk, (h_c, e_c, g_c))
    return out.reshape(b, s, d)


def setup_inputs(seed: int = 0) -> dict:
    key = jax.random.key(seed)
    ks = jax.random.split(key, 26)
    L = DEPTH

    def nrm(k, shape, scale):
        return jax.random.normal(k, shape, jnp.float32) * scale

    def gain(k, shape):
        return 1.0 + 0.02 * jax.random.normal(k, shape, jnp.float32)

    return {
        'x': nrm(ks[0], (BATCH, SEQ, D_MODEL), 1.0),
        'mem': nrm(ks[1], (BATCH, N_MEM, D_MODEL), 1.0),
        'norm_mix_g': gain(ks[2], (L, D_MODEL)),
        'w_in': nrm(ks[3], (L, D_MODEL, IN_COLS), D_MODEL ** -0.5),
        'cf_b_pw1': nrm(ks[4], (L, 2 * CF_WIDTH), 0.02),
        'sc_conv_w': nrm(ks[5], (L, SC_KERNEL, SC_WIDTH), SC_KERNEL ** -0.5),
        'sc_w_out': nrm(ks[6], (L, SC_WIDTH, D_MODEL), SC_WIDTH ** -0.5),
        'cf_conv_w': nrm(ks[7], (L, CF_KERNEL, CF_WIDTH), CF_KERNEL ** -0.5),
        'cf_conv_b': nrm(ks[8], (L, CF_WIDTH), 0.02),
        'cf_ln_g': gain(ks[9], (L, CF_WIDTH)),
        'cf_ln_b': nrm(ks[10], (L, CF_WIDTH), 0.02),
        'cf_w_pw2': nrm(ks[11], (L, CF_WIDTH, D_MODEL), CF_WIDTH ** -0.5),
        'cf_b_pw2': nrm(ks[12], (L, D_MODEL), 0.02),
        'w_mix_out': nrm(ks[13], (L, D_MODEL, D_MODEL), D_MODEL ** -0.5),
        'norm_xa_g': gain(ks[14], (L, D_MODEL)),
        'norm_mem_g': gain(ks[15], (L, D_MODEL)),
        'w_q': nrm(ks[16], (L, D_MODEL, XA_HEADS * XA_HEAD_DIM), D_MODEL ** -0.5),
        'w_kv': nrm(ks[17], (L, D_MODEL, 2 * XA_HEADS * XA_HEAD_DIM), D_MODEL ** -0.5),
        'w_xo': nrm(ks[18], (L, XA_HEADS * XA_HEAD_DIM, D_MODEL), D_MODEL ** -0.5),
        'norm_peer_g': gain(ks[19], (L, D_MODEL)),
        'w_peer_q': nrm(ks[20], (L, D_MODEL, PEER_HEADS * PEER_QDIM), D_MODEL ** -0.5),
        'peer_subkeys': nrm(ks[21], (L, 2, PEER_NKEYS, PEER_HALF), PEER_HALF ** -0.5),
        'peer_u': nrm(ks[22], (L, PEER_EXPERTS, D_MODEL), D_MODEL ** -0.5),
        'peer_v': nrm(ks[23], (L, PEER_EXPERTS, D_MODEL), PEER_HEADS ** -0.5),
        'final_norm_g': gain(ks[24], (D_MODEL,)),
    }


def reference(x, mem, norm_mix_g, w_in, cf_b_pw1, sc_conv_w, sc_w_out, cf_conv_w, cf_conv_b, cf_ln_g,
              cf_ln_b, cf_w_pw2, cf_b_pw2, w_mix_out, norm_xa_g, norm_mem_g, w_q, w_kv, w_xo, norm_peer_g,
              w_peer_q, peer_subkeys, peer_u, peer_v, final_norm_g):
    for l in range(DEPTH):
        x = x + conv_mixers(rms_norm(x, norm_mix_g[l]), w_in[l], cf_b_pw1[l], sc_conv_w[l], sc_w_out[l],
                            cf_conv_w[l], cf_conv_b[l], cf_ln_g[l], cf_ln_b[l], cf_w_pw2[l], cf_b_pw2[l],
                            w_mix_out[l])
        mem_n = rms_norm(mem, norm_mem_g[l])
        x = x + memory_cross_attention(rms_norm(x, norm_xa_g[l]), mem_n, w_q[l], w_kv[l], w_xo[l])
        x = x + peer_ffn(rms_norm(x, norm_peer_g[l]), w_peer_q[l], peer_subkeys[l], peer_u[l], peer_v[l])
    return rms_norm(x, final_norm_g)
```

```cpp
#include <hip/hip_runtime.h>
#include <cstdio>
#include <cstdint>
#include <utility>

#define NTL(p) (*(p))
#define NTS(v, p) (*(p) = (v))
#ifndef XCC_LABELS
#define XCC_LABELS 1
#endif
#ifndef MK_N_LAUNCHES
#define MK_N_LAUNCHES 1
#endif

#define DI __device__ __forceinline__
#define LAS __attribute__((address_space(3)))
__device__ __forceinline__ int tid_of_wave(int wave) { int l; asm volatile("v_mbcnt_lo_u32_b32 %0, -1, 0\n\tv_mbcnt_hi_u32_b32 %0, -1, %0" : "=v"(l)); return wave * 64 + l; }
#define GAS __attribute__((address_space(1)))

namespace pg8 {
#define PG8_LAS __attribute__((address_space(3)))
typedef unsigned short bf16_t;
typedef short bf16x8 __attribute__((ext_vector_type(8)));
typedef float f32x4 __attribute__((ext_vector_type(4)));
typedef unsigned u32x4 __attribute__((ext_vector_type(4)));
constexpr int BM = 256, BK = 64, HALF = 128, HTB = HALF * BK * 2, STAGE_BYTES = 8 * HTB, NXCD = 8, WGM = 8;

__host__ __device__ __forceinline__ int lds_byte(int r, int c) { const int st = (r >> 4) * 2 + (c >> 5), rr = r & 15, cc = c & 31, ob = rr * 64 + cc * 2; return st * 1024 + (ob ^ (((ob >> 9) & 1) << 5)); }
__host__ __device__ __forceinline__ void stage_rc(int b, int& R, int& C) { const int st = b / 1024, sb = b % 1024, swz = sb ^ (((sb >> 9) & 1) << 5); R = (st >> 1) * 16 + swz / 64; C = (st & 1) * 32 + (swz % 64) / 2; }
__host__ __device__ __forceinline__ int perm32(int rho) { const int n = rho >> 4, i = rho & 15; return 8 * (i >> 2) + 4 * n + (i & 3); }

struct Unit { int pm, pn; };
struct Gemm { const bf16_t* A; const bf16_t* Bt; int M, N, K; };

struct StaticOrder {
    int nM, nN, nwg, G, c;
    __host__ __device__ void init(int M, int N, int G_, int c_) { nM = M / BM; nN = N / BM; nwg = nM * nN; G = G_; c = c_; }
    __host__ __device__ bool next(int i, Unit& u) const {
        const long L = (long)i * G + c; if (L >= nwg) return false;
        int wgid = (int)L; { const int q = nwg / NXCD, r = nwg % NXCD, xcd = wgid % NXCD, off = wgid / NXCD; wgid = (xcd < r ? xcd * (q + 1) : r * (q + 1) + (xcd - r) * q) + off; }
        const int nig = WGM * nN, gid = wgid / nig, fm = gid * WGM, gsz = (nM - fm) < WGM ? (nM - fm) : WGM;
        u.pm = fm + ((wgid % nig) % gsz); u.pn = (wgid % nig) / gsz; return true;
    }
    __device__ __forceinline__ void a_ready(const Unit&) const {}
    __device__ __forceinline__ void done(const Unit&) const {}
};

__device__ __forceinline__ unsigned cvt_pk_bf16(float lo, float hi) { unsigned r; asm volatile("v_cvt_pk_bf16_f32 %0, %1, %2" : "=v"(r) : "v"(lo), "v"(hi)); return r; }

template <class Epi, class Sched, bool ALIGN_EPI = false, bool SP2 = false>
__device__ __forceinline__ void gemm_phase(PG8_LAS unsigned char* lds, const Gemm g, const Sched& S, const Epi& E, int wave_) {
    int tid_ = tid_of_wave(wave_); asm volatile("" : "+v"(tid_));
    const int tid = tid_, wid = __builtin_amdgcn_readfirstlane(tid >> 6), lane = tid & 63, wr = wid >> 2, wc = wid & 3, fr = lane & 15, fq = lane >> 4;
    const int K = g.K, nt = K / BK;
    unsigned voffA[2], voffB[2];
#pragma unroll
    for (int i = 0; i < 2; ++i) { int R, C; stage_rc(tid * 16 + i * 8192, R, C); const int Rb = Epi::PERM ? ((R & ~31) + perm32(R & 31)) : R;
        voffA[i] = (unsigned)(R * K + C) * 2u; voffB[i] = (unsigned)(Rb * K + C) * 2u; }
    const size_t kstep = (size_t)(BK * 2);
    const size_t hstep = (size_t)HALF * K * 2;
    const size_t tstep = 2 * hstep;
    const unsigned ldsw = (unsigned)wid * 1024u;
    const int aoff = lds_byte(wr * 64 + fr, fq * 8), boff = lds_byte(wc * 32 + fr, fq * 8);
#define PG8_SA(b, h) (((b) * 2 + (h)) * HTB)
#define PG8_SB(b, h) ((4 + (b) * 2 + (h)) * HTB)
#define PG8_STAGE(bufoff, gbase, voff) do { _Pragma("unroll") for (int _i = 0; _i < 2; ++_i) \
        __builtin_amdgcn_global_load_lds((const unsigned*)((const char*)(gbase) + (voff)[_i]), (PG8_LAS unsigned*)(lds + (bufoff) + ldsw + _i * 8192), 16, 0, 0); } while (0)
#define PG8_LDA(dst, b, h) do { _Pragma("unroll") for (int m = 0; m < 4; ++m) _Pragma("unroll") for (int k = 0; k < 2; ++k) dst[m][k] = *(const PG8_LAS bf16x8*)(lds + PG8_SA(b, h) + aoff + m * 2048 + k * 1024); } while (0)
#define PG8_LDB(dst, b, h) do { _Pragma("unroll") for (int n = 0; n < 2; ++n) _Pragma("unroll") for (int k = 0; k < 2; ++k) dst[n][k] = *(const PG8_LAS bf16x8*)(lds + PG8_SB(b, h) + boff + n * 2048 + k * 1024); } while (0)
#define PG8_MMA(ai, bj, At, Bt) do { __builtin_amdgcn_s_setprio(1); _Pragma("unroll") for (int m = 0; m < 4; ++m) _Pragma("unroll") for (int n = 0; n < 2; ++n) _Pragma("unroll") for (int k = 0; k < 2; ++k) \
        acc[ai][bj][m][n] = __builtin_amdgcn_mfma_f32_16x16x32_bf16(Bt[n][k], At[m][k], acc[ai][bj][m][n], 0, 0, 0); __builtin_amdgcn_s_setprio(0); } while (0)
#define PG8_WAIT_V(n) asm volatile("s_waitcnt vmcnt(" #n ")" ::: "memory")
#define PG8_WAIT_L(n) asm volatile("s_waitcnt lgkmcnt(" #n ")" ::: "memory")
#define PG8_BAR __builtin_amdgcn_s_barrier()
#define PG8_SCHED __builtin_amdgcn_sched_barrier(0)
    Unit cur, nxt; int ui = 0;
    if (!S.next(0, cur)) return;
    f32x4 acc[2][2][4][2];
#pragma unroll
    for (int a = 0; a < 2; ++a)
#pragma unroll
        for (int b = 0; b < 2; ++b)
#pragma unroll
            for (int m = 0; m < 4; ++m)
#pragma unroll
                for (int n = 0; n < 2; ++n) acc[a][b][m][n] = (f32x4){0.f, 0.f, 0.f, 0.f};
    bf16x8 At[4][2], B0[2][2], B1[2][2];
    const char* cA = (const char*)g.A + (size_t)cur.pm * tstep; const char* cB = (const char*)g.Bt + (size_t)cur.pn * tstep;
    S.a_ready(cur);
    if constexpr (SP2) {
        PG8_STAGE(PG8_SB(0, 0), cB, voffB); PG8_STAGE(PG8_SB(0, 1), cB + hstep, voffB); PG8_STAGE(PG8_SA(0, 0), cA, voffA); PG8_STAGE(PG8_SA(0, 1), cA + hstep, voffA);
        if (wr == 1) PG8_BAR;
        PG8_WAIT_V(2); PG8_BAR;
        PG8_STAGE(PG8_SB(1, 0), cB + kstep, voffB); PG8_STAGE(PG8_SA(1, 0), cA + kstep, voffA); PG8_STAGE(PG8_SB(1, 1), cB + hstep + kstep, voffB);
        PG8_WAIT_V(6); PG8_BAR;
    } else {
        PG8_STAGE(PG8_SB(0, 0), cB, voffB); PG8_STAGE(PG8_SA(0, 0), cA, voffA); PG8_STAGE(PG8_SB(0, 1), cB + hstep, voffB); PG8_STAGE(PG8_SA(0, 1), cA + hstep, voffA);
        if (wr == 1) PG8_BAR;
        PG8_WAIT_V(4); PG8_BAR;
        PG8_STAGE(PG8_SB(1, 0), cB + kstep, voffB); PG8_STAGE(PG8_SA(1, 0), cA + kstep, voffA); PG8_STAGE(PG8_SB(1, 1), cB + hstep + kstep, voffB);
        PG8_WAIT_V(6); PG8_BAR;
    }
    for (;;) {
        const bool has_next = S.next(ui + 1, nxt);
        const char* nA = has_next ? (const char*)g.A + (size_t)nxt.pm * tstep : cA; const char* nB = has_next ? (const char*)g.Bt + (size_t)nxt.pn * tstep : cB;
        for (int t = 0; t < nt; t += 2) {
            const bool last = (t == nt - 2);
            const char* a1 = cA + (size_t)(t + 1) * kstep;
            const char* a2 = last ? nA : cA + (size_t)(t + 2) * kstep; const char* b2 = last ? nB : cB + (size_t)(t + 2) * kstep;
            const char* a3 = a2 + kstep; const char* b3 = b2 + kstep;
            if (last && has_next) S.a_ready(nxt);
            if constexpr (SP2) {
            PG8_LDB(B0, 0, 0); PG8_LDB(B1, 0, 1); PG8_SCHED; PG8_LDA(At, 0, 0); PG8_STAGE(PG8_SA(1, 1), a1 + hstep, voffA);
            PG8_WAIT_V(8); PG8_WAIT_L(0); PG8_BAR; PG8_MMA(0, 0, At, B0); PG8_MMA(0, 1, At, B1); PG8_BAR; PG8_SCHED;
            PG8_LDA(At, 0, 1); PG8_STAGE(PG8_SB(0, 0), b2, voffB); PG8_STAGE(PG8_SB(0, 1), b2 + hstep, voffB); PG8_STAGE(PG8_SA(0, 0), a2, voffA);
            PG8_WAIT_V(8); PG8_WAIT_L(0); PG8_BAR; PG8_MMA(1, 0, At, B0); PG8_MMA(1, 1, At, B1); PG8_BAR; PG8_SCHED;
            PG8_LDB(B0, 1, 0); PG8_LDB(B1, 1, 1); PG8_SCHED; PG8_LDA(At, 1, 0); PG8_STAGE(PG8_SA(0, 1), a2 + hstep, voffA);
            PG8_WAIT_V(8); PG8_WAIT_L(0); PG8_BAR; PG8_MMA(0, 0, At, B0); PG8_MMA(0, 1, At, B1); PG8_BAR; PG8_SCHED;
            PG8_LDA(At, 1, 1); PG8_STAGE(PG8_SB(1, 0), b3, voffB); PG8_STAGE(PG8_SB(1, 1), b3 + hstep, voffB); PG8_STAGE(PG8_SA(1, 0), a3, voffA);
            PG8_WAIT_V(8); PG8_WAIT_L(0); PG8_BAR; PG8_MMA(1, 0, At, B0); PG8_MMA(1, 1, At, B1); PG8_BAR; PG8_SCHED;
            } else {
            PG8_LDB(B0, 0, 0); PG8_SCHED; PG8_LDA(At, 0, 0); PG8_STAGE(PG8_SA(1, 1), a1 + hstep, voffA);
            PG8_WAIT_L(8); PG8_BAR; PG8_WAIT_L(0); PG8_MMA(0, 0, At, B0); PG8_BAR; PG8_SCHED;
            PG8_LDB(B1, 0, 1); PG8_STAGE(PG8_SB(0, 0), b2, voffB);
            PG8_BAR; PG8_WAIT_L(0); PG8_MMA(0, 1, At, B1); PG8_BAR;
            PG8_LDA(At, 0, 1); PG8_STAGE(PG8_SA(0, 0), a2, voffA);
            PG8_BAR; PG8_WAIT_L(0); PG8_MMA(1, 0, At, B0); PG8_BAR; PG8_SCHED;
            PG8_STAGE(PG8_SB(0, 1), b2 + hstep, voffB);
            PG8_WAIT_V(6); PG8_BAR; PG8_MMA(1, 1, At, B1); PG8_BAR;
            PG8_LDB(B0, 1, 0); PG8_SCHED; PG8_LDA(At, 1, 0); PG8_STAGE(PG8_SA(0, 1), a2 + hstep, voffA);
            PG8_WAIT_L(8); PG8_BAR; PG8_WAIT_L(0); PG8_MMA(0, 0, At, B0); PG8_BAR; PG8_SCHED;
            PG8_LDB(B1, 1, 1); PG8_STAGE(PG8_SB(1, 0), b3, voffB);
            PG8_BAR; PG8_WAIT_L(0); PG8_MMA(0, 1, At, B1); PG8_BAR;
            PG8_LDA(At, 1, 1); PG8_STAGE(PG8_SA(1, 0), a3, voffA);
            PG8_BAR; PG8_WAIT_L(0); PG8_MMA(1, 0, At, B0); PG8_BAR; PG8_SCHED;
            PG8_STAGE(PG8_SB(1, 1), b3 + hstep, voffB);
            PG8_WAIT_V(6); PG8_BAR; PG8_MMA(1, 1, At, B1); PG8_BAR;
            }
        }
        if constexpr (ALIGN_EPI) { if (wr == 0) PG8_BAR; }
        E(acc, cur, wr, wc, fr, fq); S.done(cur);
        if (!has_next) break;
#pragma unroll
        for (int a = 0; a < 2; ++a)
#pragma unroll
            for (int b = 0; b < 2; ++b)
#pragma unroll
                for (int m = 0; m < 4; ++m)
#pragma unroll
                    for (int n = 0; n < 2; ++n) acc[a][b][m][n] = (f32x4){0.f, 0.f, 0.f, 0.f};
        cur = nxt; cA = nA; cB = nB; ++ui;
        if constexpr (ALIGN_EPI) { if (wr == 1) PG8_BAR; }
    }
    PG8_WAIT_V(0);
    if constexpr (!ALIGN_EPI) { if (wr == 0) PG8_BAR; }
    PG8_BAR;
#undef PG8_SA
#undef PG8_SB
#undef PG8_STAGE
#undef PG8_LDA
#undef PG8_LDB
#undef PG8_MMA
#undef PG8_WAIT_V
#undef PG8_WAIT_L
#undef PG8_BAR
#undef PG8_SCHED
}
}

#ifndef PG8_SP2
#define PG8_SP2 true
#endif
#ifndef PG8_ALIGN
#define PG8_ALIGN true
#endif

constexpr int NWAVES = 8;
constexpr int N_LAUNCHES = MK_N_LAUNCHES;
constexpr int NPH = 15;
constexpr int D = 1024, BATCH = 8, SEQ = 4096, T = BATCH * SEQ, NMEM = 256, MROWS = BATCH * NMEM;
constexpr int INC = 7168, NEXP = 16384;
constexpr float EPS = 1e-6f;
constexpr float LOG2E = 1.4426950408889634f;

constexpr size_t MiB = 1u << 20;
constexpr size_t WS_CTL = 0, CTL_ZERO_BYTES = 1 * MiB;
constexpr size_t WS_SS1 = 256 * 1024, WS_SS2 = 512 * 1024;
constexpr float SS_FIX = 16777216.0f, SS_UNFIX = 1.0f / 16777216.0f;
DI float ss_get(const unsigned long long* p, int r) { return (float)p[r] * SS_UNFIX; }
constexpr size_t WS_WIN = 1 * MiB, WS_WSC = 15 * MiB, WS_WPW2 = 17 * MiB, WS_WMIX = 19 * MiB, WS_WQ = 21 * MiB, WS_WXO = 23 * MiB, WS_WKV = 25 * MiB, WS_WPQ = 29 * MiB;
constexpr size_t WS_SKB = 33 * MiB, WS_RS0 = 33 * MiB + 128 * 1024, WS_RSM = 33 * MiB + 256 * 1024;
constexpr size_t WS_KB = 34 * MiB, WS_VT = 38 * MiB, WS_UB = 42 * MiB, WS_VB = 58 * MiB;
constexpr float U_SCALE = 64.0f, V_SCALE = 6.0f, A_SCALE = 16.0f;
constexpr size_t WS_S0 = 106 * MiB, WS_S1 = 170 * MiB, WS_S2 = 234 * MiB, WS_S3 = 298 * MiB, WS_S4 = 362 * MiB, WS_S5 = 426 * MiB, WS_END = 490 * MiB;
constexpr int CW_TMO = 0, CW_CODE = 1, CW_BAR = 4096, CW_XRANK = 8192;

constexpr int RING_OFF = 0, RING_BYTES = 131072;
constexpr int LDSCTL_OFF = RING_BYTES, MISC_OFF = LDSCTL_OFF + 320;
constexpr int LDS_BYTES = 163840, ZACC_OFF = LDSCTL_OFF + 3072;

typedef unsigned short bf16;
typedef unsigned v4u __attribute__((ext_vector_type(4)));
typedef unsigned v2u __attribute__((ext_vector_type(2)));
typedef float f32x4 __attribute__((ext_vector_type(4)));
typedef float f32x2 __attribute__((ext_vector_type(2)));
typedef float f32x16 __attribute__((ext_vector_type(16)));
typedef int i32x2 __attribute__((ext_vector_type(2)));
typedef int i32x4 __attribute__((ext_vector_type(4)));
typedef int i32x8 __attribute__((ext_vector_type(8)));
typedef short bf16x8 __attribute__((ext_vector_type(8)));
typedef __bf16 bf2_t __attribute__((ext_vector_type(2)));
typedef GAS unsigned gu32;
#define RLX_AGENT __ATOMIC_RELAXED, __HIP_MEMORY_SCOPE_AGENT
#define LDS_WAIT() asm volatile("s_waitcnt lgkmcnt(0)" ::: "memory")
#define VM_WAIT() asm volatile("s_waitcnt vmcnt(0)" ::: "memory")
DI unsigned f2bf(float f) { unsigned u = __builtin_bit_cast(unsigned, f); return (u + 0x7fffu + ((u >> 16) & 1u)) >> 16; }
DI unsigned pk2(float lo, float hi) { return pg8::cvt_pk_bf16(lo, hi); }
DI float bflo(unsigned w) { return __builtin_bit_cast(float, w << 16); }
DI float bfhi(unsigned w) { return __builtin_bit_cast(float, w & 0xffff0000u); }
DI float sigmoidf_(float x) { return __builtin_amdgcn_rcpf(1.0f + __builtin_amdgcn_exp2f(-x * LOG2E)); }
DI float fmax_(float a, float b) { float r; asm("v_max_f32_e32 %0, %1, %2" : "=v"(r) : "v"(a), "v"(b)); return r; }
DI float fmin_(float a, float b) { float r; asm("v_min_f32_e32 %0, %1, %2" : "=v"(r) : "v"(a), "v"(b)); return r; }

#define XB_TMO      128
#define XB_XCNT(j)  (256  + 64 * (j))
#define XB_XSUB(j)  (1280 + 64 * (j))
#define XB_XGEN(j)  (2304 + 64 * (j))
#define XB_TOP      3328
#define XB_TOPGEN   3392
#define XCD_BAR_WORDS 3456
#define XB_SPIN_CAP (1u << 18)
DI unsigned xb_ld(unsigned* p)              { return __hip_atomic_load(p, __ATOMIC_RELAXED, __HIP_MEMORY_SCOPE_AGENT); }
DI unsigned xb_add(unsigned* p, unsigned v) { return __hip_atomic_fetch_add(p, v, __ATOMIC_RELAXED, __HIP_MEMORY_SCOPE_AGENT); }
DI unsigned xb_xcc_id() { return (unsigned)__builtin_amdgcn_s_getreg((3 << 11) | 20) & 0xFu; }
#define XB_SPIN(cond, bar) do { unsigned _sp = 0; while (cond) { __builtin_amdgcn_s_sleep(1); \
    if ((++_sp & 255u) == 0u) { if (xb_ld(&(bar)[XB_TMO])) break; if (_sp > XB_SPIN_CAP) { atomicAdd(&(bar)[XB_TMO], 1u); break; } } } } while (0)
struct XcdBarrier { unsigned* bar; unsigned x; volatile LAS unsigned* st; int wv; };
DI XcdBarrier xcd_barrier_post(unsigned* bar, volatile LAS unsigned* st) {
    XcdBarrier b; b.bar = bar; b.x = xb_xcc_id(); b.st = st;
    if (threadIdx.x == 0) (void)xb_add(&bar[XB_XCNT(b.x)], 1u);
    return b;
}
DI void xcd_barrier_complete(unsigned* bar, unsigned x, unsigned& nloc, unsigned& nx) {
    const unsigned G = gridDim.x * gridDim.y * gridDim.z;
    unsigned sum, cnt, mine, sp = 0u;
    for (;;) {
        sum = 0u; cnt = 0u; mine = 0u;
#pragma unroll
        for (unsigned j = 0; j < 16; ++j) { const unsigned c = xb_ld(&bar[XB_XCNT(j)]); sum += c; cnt += (c > 0u) ? 1u : 0u; mine = (j == x) ? c : mine; }
        if (sum == G) break;
        __builtin_amdgcn_s_sleep(1);
        if ((++sp & 255u) == 0u) { if (xb_ld(&bar[XB_TMO])) break; if (sp > XB_SPIN_CAP) { atomicAdd(&bar[XB_TMO], 1u); break; } }
    }
    nloc = mine > 0u ? mine : 1u; nx = cnt > 0u ? cnt : 1u;
}
DI void xcd_barrier(const XcdBarrier& b) {
    asm volatile("s_waitcnt vmcnt(0)" ::: "memory");
    __syncthreads();
    if (tid_of_wave(b.wv) == 0) {
        unsigned* bar = b.bar;
        __builtin_amdgcn_s_waitcnt(0);
        unsigned nloc = b.st[0], nx = b.st[1];
        if (nloc == 0u) { xcd_barrier_complete(bar, b.x, nloc, nx); b.st[0] = nloc; b.st[1] = nx; }
        const unsigned old = xb_add(&bar[XB_XSUB(b.x)], 1u);
        const unsigned gen = old / nloc;
        if (old + 1u == (gen + 1u) * nloc) {
            __builtin_amdgcn_fence(__ATOMIC_RELEASE, "agent");
            asm volatile("s_waitcnt vmcnt(0)" ::: "memory");
            const unsigned og = xb_add(&bar[XB_TOP], 1u);
            const unsigned tg = og / nx;
            if (og + 1u == (tg + 1u) * nx) xb_add(&bar[XB_TOPGEN], 1u);
            else XB_SPIN(xb_ld(&bar[XB_TOPGEN]) == tg, bar);
            __builtin_amdgcn_fence(__ATOMIC_ACQUIRE, "agent");
            xb_add(&bar[XB_XGEN(b.x)], 1u);
            asm volatile("s_waitcnt vmcnt(0)" ::: "memory");
        } else {
            XB_SPIN(xb_ld(&bar[XB_XGEN(b.x)]) == gen, bar);
            __builtin_amdgcn_fence(__ATOMIC_ACQUIRE, "agent");
            asm volatile("s_waitcnt vmcnt(0)" ::: "memory");
        }
    }
    __syncthreads();
}

struct Args { const float* in[25]; float* out; unsigned char* ws; int ph_lo, ph_hi, li, pad; };
enum { I_X = 0, I_MEM, I_NMIXG, I_WIN, I_CFB1, I_SCCW, I_SCWO, I_CFCW, I_CFCB, I_LNG, I_LNB, I_PW2, I_BPW2, I_WMIX, I_NXAG, I_NMEMG, I_WQ, I_WKV, I_WXO, I_NPEERG, I_WPQ, I_SUBK, I_PU, I_PV, I_FING };

struct Ctx { LAS unsigned char* lds; int tid, lane, wave, vcu, G; int xj, xrank, xn; };

DI Ctx fresh(const Ctx& F) { Ctx G = F; int t = tid_of_wave(F.wave); asm volatile("" : "+v"(t)); G.tid = t; G.lane = t & 63; return G; }
DI float wave_sum(float v) {
#pragma unroll
    for (int o = 1; o < 64; o <<= 1) v += __shfl_xor(v, o);
    return v;
}

template <int N, int LOGN> DI float treduce(float (&v)[N], int lane) {
#pragma unroll
    for (int s = 0; s < LOGN; ++s) {
        const int c = N >> (s + 1), mask = 32 >> s;
        const bool up = (lane & mask) != 0;
#pragma unroll
        for (int i = 0; i < c; ++i) { float lo = v[i], hi = v[i + c]; asm volatile("" : "+v"(lo), "+v"(hi));
            const float keep = up ? hi : lo; const float send = up ? lo : hi; v[i] = keep + __shfl_xor(send, mask); }
    }
    float r = v[0];
#pragma unroll
    for (int s = LOGN; s < 6; ++s) r += __shfl_xor(r, 32 >> s);
    return r;
}

DI void p0_transpose_item(const float* W, int K, int N, bf16* WT, const float* g, int k0, int c0, int n0d, LAS float* scr, int lane) {
#pragma unroll 8
    for (int i = 0; i < 32; ++i) { const int kk = 2 * i + (lane >> 5); const float s = g ? g[k0 + kk] : 1.0f; scr[kk * 33 + (lane & 31)] = __builtin_nontemporal_load(W + (size_t)(k0 + kk) * N + c0 + (lane & 31)) * s; }
    LDS_WAIT(); asm volatile("" ::: "memory");
    const int c = lane & 7;
#pragma unroll
    for (int j = 0; j < 4; ++j) { const int n = (lane >> 3) + 8 * j; const LAS float* s = scr + (8 * c) * 33 + n;
        v4u o; o.x = pk2(s[0 * 33], s[1 * 33]); o.y = pk2(s[2 * 33], s[3 * 33]); o.z = pk2(s[4 * 33], s[5 * 33]); o.w = pk2(s[6 * 33], s[7 * 33]);
        *(GAS v4u*)(WT + (size_t)(n0d + n) * K + k0 + 8 * c) = o; }
    LDS_WAIT(); asm volatile("" ::: "memory");
}
DI int win_src_col(int nd) {
    if (nd < 1024) return nd;
    if (nd < 3072) { const int q = (nd - 1024) >> 8, j = (nd - 1024) & 255; return 1024 + (j >> 7) * 1024 + 128 * q + (j & 127); }
    if (nd < 5120) { const int q = (nd - 3072) >> 8, j = (nd - 3072) & 255; return 3072 + (j >> 7) * 1024 + 128 * q + (j & 127); }
    return nd;
}
template <int NR, bool PRESCALE = false> DI void rows_to_bf16_rs(const float* x0, bf16* o0, float* rs, int lane) {
    f32x4 v[NR][4];
#pragma unroll
    for (int q = 0; q < NR; ++q) { const GAS f32x4* xr = (const GAS f32x4*)(x0 + (size_t)q * D) + lane;
#pragma unroll
        for (int j = 0; j < 4; ++j) v[q][j] = __builtin_nontemporal_load(xr + 64 * j); }
#pragma unroll
    for (int q = 0; q < NR; ++q) {
        float s = 0.f;
#pragma unroll
        for (int j = 0; j < 4; ++j) s += (v[q][j].x * v[q][j].x + v[q][j].y * v[q][j].y) + (v[q][j].z * v[q][j].z + v[q][j].w * v[q][j].w);
        s = wave_sum(s);
        const float rsv = 1.0f / sqrtf(s * (1.0f / D) + EPS), ps = PRESCALE ? rsv : 1.0f;
        GAS v2u* o8 = (GAS v2u*)(o0 + (size_t)q * D) + lane;
#pragma unroll
        for (int j = 0; j < 4; ++j) { v2u w; w.x = pk2(v[q][j].x * ps, v[q][j].y * ps); w.y = pk2(v[q][j].z * ps, v[q][j].w * ps); o8[64 * j] = w; }
        if (lane == 0) rs[q] = rsv;
    }
}

DI void p0_prologue(const Args& a, const Ctx& F) {
    unsigned char* ws = a.ws;
    LAS float* scr = (LAS float*)(F.lds + RING_OFF + F.wave * 16384);
    const int gw = F.vcu * NWAVES + F.wave, NGW = F.G * NWAVES;
    {
        LAS float* tile = (LAS float*)(F.lds + RING_OFF);
        constexpr int NB_IN = INC / 256, NI_IN = 16 * NB_IN, NI_SQ = 16 * 4, NI_2K = 16 * 8, NITEMS = NI_IN + 5 * NI_SQ + 2 * NI_2K;
        for (int it = F.vcu; it < NITEMS; it += F.G) {
            const float* W; const float* g = nullptr; bf16* WT; int N, kb, nb; bool perm = false;
            int rr = it;
            if (rr < NI_IN) { W = a.in[I_WIN]; g = a.in[I_NMIXG]; WT = (bf16*)(ws + WS_WIN); N = INC; kb = rr / NB_IN; nb = rr % NB_IN; perm = true; }
            else { rr -= NI_IN;
                if (rr < 5 * NI_SQ) { const int mi = rr / NI_SQ, q = rr % NI_SQ; kb = q / 4; nb = q % 4; N = D;
                    W = mi == 0 ? a.in[I_SCWO] : mi == 1 ? a.in[I_PW2] : mi == 2 ? a.in[I_WMIX] : mi == 3 ? a.in[I_WQ] : a.in[I_WXO];
                    WT = (bf16*)(ws + (mi == 0 ? WS_WSC : mi == 1 ? WS_WPW2 : mi == 2 ? WS_WMIX : mi == 3 ? WS_WQ : WS_WXO)); g = mi == 3 ? a.in[I_NXAG] : nullptr; }
                else { rr -= 5 * NI_SQ; const int mi = rr / NI_2K, q = rr % NI_2K; kb = q / 8; nb = q % 8; N = 2048;
                    W = mi == 0 ? a.in[I_WKV] : a.in[I_WPQ]; WT = (bf16*)(ws + (mi == 0 ? WS_WKV : WS_WPQ)); g = mi == 0 ? a.in[I_NMEMG] : a.in[I_NPEERG]; } }
            const int k0 = 64 * kb, n0 = 256 * nb;
            const int c_lo = perm ? win_src_col(n0) : n0, c_hi = perm ? win_src_col(n0 + 128) : n0 + 128;
            const int csrc = ((F.lane >> 5) ? c_hi : c_lo) + 4 * (F.lane & 31);
#pragma unroll
            for (int q = 0; q < 8; ++q) { const int kl = 8 * F.wave + q; const float s = g ? g[k0 + kl] : 1.0f;
                const f32x4 v = __builtin_nontemporal_load((const GAS f32x4*)(W + (size_t)(k0 + kl) * N + csrc));
                LAS float* tp = tile + kl * 257 + 4 * F.lane; tp[0] = v.x * s; tp[1] = v.y * s; tp[2] = v.z * s; tp[3] = v.w * s; }
            __syncthreads();
            const int c = F.tid & 7;
#pragma unroll
            for (int q = 0; q < 4; ++q) { const int nl = (F.tid >> 3) + 64 * q; const LAS float* tp = tile + (8 * c) * 257 + nl;
                v4u o; o.x = pk2(tp[0], tp[257]); o.y = pk2(tp[2 * 257], tp[3 * 257]); o.z = pk2(tp[4 * 257], tp[5 * 257]); o.w = pk2(tp[6 * 257], tp[7 * 257]);
                *(GAS v4u*)(WT + (size_t)(n0 + nl) * D + k0 + 8 * c) = o; }
            __syncthreads();
        }
    }
    {
        const GAS f32x4* pg = (const GAS f32x4*)a.in[I_NPEERG];
        f32x4 g4[4];
#pragma unroll
        for (int q = 0; q < 4; ++q) g4[q] = pg[F.lane + 64 * q];
        unsigned char* ub = ws + WS_UB; unsigned char* vb = ws + WS_VB;
#pragma unroll 2
        for (int e = gw; e < NEXP; e += NGW) {
            const GAS f32x4* pu = (const GAS f32x4*)(a.in[I_PU] + (size_t)e * D) + F.lane; const GAS f32x4* pv = (const GAS f32x4*)(a.in[I_PV] + (size_t)e * D) + F.lane;
            f32x4 u[4], v[4];
#pragma unroll
            for (int q = 0; q < 4; ++q) { u[q] = __builtin_nontemporal_load(pu + 64 * q); v[q] = __builtin_nontemporal_load(pv + 64 * q); }
#pragma unroll
            for (int q = 0; q < 4; ++q) {
                const f32x4 uu = u[q] * g4[q] * U_SCALE, vv = v[q] * V_SCALE; unsigned uw = 0u, vw = 0u;
                uw = __builtin_amdgcn_cvt_scalef32_pk_fp4_f32(uw, uu.x, uu.y, 1.0f, 0); uw = __builtin_amdgcn_cvt_scalef32_pk_fp4_f32(uw, uu.z, uu.w, 1.0f, 1);
                vw = __builtin_amdgcn_cvt_scalef32_pk_fp4_f32(vw, vv.x, vv.y, 1.0f, 0); vw = __builtin_amdgcn_cvt_scalef32_pk_fp4_f32(vw, vv.z, vv.w, 1.0f, 1);
                *(GAS unsigned short*)(ub + ((size_t)q * NEXP + e) * 128 + 2 * F.lane) = (unsigned short)uw;
                *(GAS unsigned short*)(vb + ((size_t)q * NEXP + e) * 128 + 2 * F.lane) = (unsigned short)vw; }
        }
        const int gt = F.vcu * (NWAVES * 64) + F.tid, NGT = F.G * NWAVES * 64;
        const GAS f32x4* sk = (const GAS f32x4*)a.in[I_SUBK]; GAS v4u* skb = (GAS v4u*)(ws + WS_SKB);
        for (int i = gt; i < 2 * 128 * 128 / 8; i += NGT) {
            const f32x4 v0 = sk[2 * i], v1 = sk[2 * i + 1];
            v4u p; p.x = pk2(v0.x, v0.y); p.y = pk2(v0.z, v0.w); p.z = pk2(v1.x, v1.y); p.w = pk2(v1.z, v1.w);
            skb[i] = p;
        }
    }
    for (int m = 4 * gw; m < T; m += 4 * NGW) rows_to_bf16_rs<4, true>(a.in[I_X] + (size_t)m * D, (bf16*)(ws + WS_S0) + (size_t)m * D, (float*)(ws + WS_RS0) + m, F.lane);
    for (int m = gw; m < MROWS; m += NGW) rows_to_bf16_rs<1, true>(a.in[I_MEM] + (size_t)m * D, (bf16*)a.out + (size_t)m * D, (float*)(ws + WS_RSM) + m, F.lane);
}

using pg8::Unit;
typedef pg8::f32x4 A4;
#define EPI_ROWS(u, wr, fr) ((u).pm * 256 + (wr) * 64 + (fr))
DI v4u pack8(const A4& v0, const A4& v1) { v4u w; w.x = pk2(v0[0], v0[1]); w.y = pk2(v0[2], v0[3]); w.z = pk2(v1[0], v1[1]); w.w = pk2(v1[2], v1[3]); return w; }
DI void unpack8(const v4u w, A4& v0, A4& v1) { v0 = (A4){bflo(w.x), bfhi(w.x), bflo(w.y), bfhi(w.y)}; v1 = (A4){bflo(w.z), bfhi(w.z), bflo(w.w), bfhi(w.w)}; }
DI A4 sig4(const A4& v) { return (A4){sigmoidf_(v[0]), sigmoidf_(v[1]), sigmoidf_(v[2]), sigmoidf_(v[3])}; }

struct EpiIn {
    static constexpr bool PERM = true;
    const float* rs0; const float* b1; unsigned char* wsb;
    DI void operator()(const A4 (&acc)[2][2][4][2], const Unit& u, int wr, int wc, int fr, int fq) const {
        const int pn = u.pn, row0 = EPI_ROWS(u, wr, fr), cw = wc * 32 + 8 * fq;
        bf16* const cx = (bf16*)(wsb + WS_S2); bf16* const glu = (bf16*)(wsb + WS_S3);
        if (pn < 4 || pn >= 20) {
            const size_t ooff = pn < 4 ? WS_S1 : (pn < 24 ? WS_S4 : WS_S5);
            bf16* O = (bf16*)(wsb + ooff); const int colt = (pn < 4 ? pn : (pn < 24 ? pn - 20 : pn - 24)) * 256; const bool sg = pn >= 20;
#pragma unroll
            for (int ai = 0; ai < 2; ++ai)
#pragma unroll
                for (int m = 0; m < 4; ++m) { const int r = row0 + ai * 128 + m * 16; const float s = 1.0f;
#pragma unroll
                    for (int bj = 0; bj < 2; ++bj) { A4 v0 = acc[ai][bj][m][0] * s, v1 = acc[ai][bj][m][1] * s; if (sg) { v0 = sig4(v0); v1 = sig4(v1); }
                        __builtin_nontemporal_store(pack8(v0, v1), (GAS v4u*)(O + (size_t)r * D + colt + bj * 128 + cw)); } }
        } else if (pn < 12) {
            const int ch = (pn - 4) * 128 + cw;
#pragma unroll
            for (int ai = 0; ai < 2; ++ai)
#pragma unroll
                for (int m = 0; m < 4; ++m) { const int r = row0 + ai * 128 + m * 16; const float s2 = 1.0f;
                    const A4 v0 = acc[ai][0][m][0] * acc[ai][1][m][0] * s2, v1 = acc[ai][0][m][1] * acc[ai][1][m][1] * s2;
                    __builtin_nontemporal_store(pack8(v0, v1), (GAS v4u*)(cx + (size_t)r * D + ch)); }
        } else {
            const int ch = (pn - 12) * 128 + cw;
            const A4 ba0 = *(const A4*)(b1 + ch), ba1 = *(const A4*)(b1 + ch + 4), bg0 = *(const A4*)(b1 + 1024 + ch), bg1 = *(const A4*)(b1 + 1024 + ch + 4);
#pragma unroll
            for (int ai = 0; ai < 2; ++ai)
#pragma unroll
                for (int m = 0; m < 4; ++m) { const int r = row0 + ai * 128 + m * 16; const float s = 1.0f;
                    const A4 v0 = (acc[ai][0][m][0] * s + ba0) * sig4(acc[ai][1][m][0] * s + bg0), v1 = (acc[ai][0][m][1] * s + ba1) * sig4(acc[ai][1][m][1] * s + bg1);
                    __builtin_nontemporal_store(pack8(v0, v1), (GAS v4u*)(glu + (size_t)r * D + ch)); }
        }
    }
};
struct EpiKV {
    static constexpr bool PERM = true;
    const float* rsm; bf16* kb; bf16* vt;
    DI void operator()(const A4 (&acc)[2][2][4][2], const Unit& u, int wr, int wc, int fr, int fq) const {
        const int pn = u.pn, row0 = EPI_ROWS(u, wr, fr), cw = wc * 32 + 8 * fq;
#pragma unroll
        for (int ai = 0; ai < 2; ++ai)
#pragma unroll
            for (int m = 0; m < 4; ++m) { const int r = row0 + ai * 128 + m * 16; const float s = rsm[r];
#pragma unroll
                for (int bj = 0; bj < 2; ++bj) { const A4 v0 = acc[ai][bj][m][0] * s, v1 = acc[ai][bj][m][1] * s;
                    if (pn < 4) *(GAS v4u*)(kb + (size_t)r * D + pn * 256 + bj * 128 + cw) = pack8(v0, v1);
                    else { const int b = r >> 8, key = r & 255, k16 = key & 15, pos = (key & ~15) + 8 * ((k16 >> 2) & 1) + 4 * (k16 >> 3) + (k16 & 3);
                        const int col = (pn - 4) * 256 + bj * 128 + cw; bf16* p = vt + ((size_t)(b * 1024 + col)) * 256 + pos;
#pragma unroll
                        for (int i = 0; i < 4; ++i) { p[(size_t)i * 256] = (bf16)f2bf(v0[i]); p[(size_t)(4 + i) * 256] = (bf16)f2bf(v1[i]); } } } }
    }
};
struct EpiMulGate {
    static constexpr bool PERM = true;
    const bf16* gate; bf16* out;
    DI void operator()(const A4 (&acc)[2][2][4][2], const Unit& u, int wr, int wc, int fr, int fq) const {
        const int row0 = EPI_ROWS(u, wr, fr), c0 = u.pn * 256 + wc * 32 + 8 * fq;
        v4u gv[2][4][2];
#pragma unroll
        for (int ai = 0; ai < 2; ++ai)
#pragma unroll
            for (int m = 0; m < 4; ++m)
#pragma unroll
                for (int bj = 0; bj < 2; ++bj) gv[ai][m][bj] = *(const GAS v4u*)(gate + (size_t)(row0 + ai * 128 + m * 16) * D + c0 + bj * 128);
        __builtin_amdgcn_sched_barrier(0);
#pragma unroll
        for (int ai = 0; ai < 2; ++ai)
#pragma unroll
            for (int m = 0; m < 4; ++m) { const size_t ro = (size_t)(row0 + ai * 128 + m * 16) * D + c0;
#pragma unroll
                for (int bj = 0; bj < 2; ++bj) { A4 g0, g1; unpack8(gv[ai][m][bj], g0, g1);
                    *(GAS v4u*)(out + ro + bj * 128) = pack8(acc[ai][bj][m][0] * g0, acc[ai][bj][m][1] * g1); } }
    }
};
struct EpiMerge {
    static constexpr bool PERM = true;
    const bf16* gate; const bf16* add; const float* bias; bf16* out;
    DI void operator()(const A4 (&acc)[2][2][4][2], const Unit& u, int wr, int wc, int fr, int fq) const {
        const int row0 = EPI_ROWS(u, wr, fr), c0 = u.pn * 256 + wc * 32 + 8 * fq;
        A4 bv[2][2];
#pragma unroll
        for (int bj = 0; bj < 2; ++bj) { bv[bj][0] = *(const A4*)(bias + c0 + bj * 128); bv[bj][1] = *(const A4*)(bias + c0 + bj * 128 + 4); }
#pragma unroll
        for (int ai = 0; ai < 2; ++ai) {
            v4u gv[4][2], tv[4][2];
#pragma unroll
            for (int m = 0; m < 4; ++m)
#pragma unroll
                for (int bj = 0; bj < 2; ++bj) { const size_t ro = (size_t)(row0 + ai * 128 + m * 16) * D + c0 + bj * 128; gv[m][bj] = *(const GAS v4u*)(gate + ro); tv[m][bj] = *(const GAS v4u*)(add + ro); }
            __builtin_amdgcn_sched_barrier(0);
#pragma unroll
            for (int m = 0; m < 4; ++m) { const size_t ro = (size_t)(row0 + ai * 128 + m * 16) * D + c0;
#pragma unroll
                for (int bj = 0; bj < 2; ++bj) { A4 g0, g1, t0, t1; unpack8(gv[m][bj], g0, g1); unpack8(tv[m][bj], t0, t1);
                    *(GAS v4u*)(out + ro + bj * 128) = pack8(t0 + (acc[ai][bj][m][0] + bv[bj][0]) * g0, t1 + (acc[ai][bj][m][1] + bv[bj][1]) * g1); } }
        }
    }
};
template <bool BF> struct EpiResid {
    static constexpr bool PERM = true;
    const void* base; bf16* out; unsigned long long* ss;
    DI void operator()(const A4 (&acc)[2][2][4][2], const Unit& u, int wr, int wc, int fr, int fq) const {
        const int row0 = EPI_ROWS(u, wr, fr), c0 = u.pn * 256 + wc * 32 + 8 * fq;
#pragma unroll
        for (int ai = 0; ai < 2; ++ai) {
            A4 bb[4][2][2];
#pragma unroll
            for (int m = 0; m < 4; ++m)
#pragma unroll
                for (int bj = 0; bj < 2; ++bj) { const size_t ro = (size_t)(row0 + ai * 128 + m * 16) * D + c0 + bj * 128;
                    if (BF) unpack8(*(const GAS v4u*)((const bf16*)base + ro), bb[m][bj][0], bb[m][bj][1]);
                    else { bb[m][bj][0] = __builtin_nontemporal_load((const GAS A4*)((const float*)base + ro)); bb[m][bj][1] = __builtin_nontemporal_load((const GAS A4*)((const float*)base + ro + 4)); } }
            __builtin_amdgcn_sched_barrier(0);
#pragma unroll
            for (int m = 0; m < 4; ++m) { const int r = row0 + ai * 128 + m * 16; const size_t ro = (size_t)r * D + c0; float q = 0.f;
#pragma unroll
                for (int bj = 0; bj < 2; ++bj) { const A4 b0 = bb[m][bj][0], b1 = bb[m][bj][1];
                    const A4 v0 = b0 + acc[ai][bj][m][0], v1 = b1 + acc[ai][bj][m][1];
                    q += (v0[0] * v0[0] + v0[1] * v0[1]) + (v0[2] * v0[2] + v0[3] * v0[3]) + (v1[0] * v1[0] + v1[1] * v1[1]) + (v1[2] * v1[2] + v1[3] * v1[3]);
                    *(GAS v4u*)(out + ro + bj * 128) = pack8(v0, v1); }
                q += __shfl_xor(q, 16); q += __shfl_xor(q, 32);
                if (fq == 0) atomicAdd(ss + r, (unsigned long long)(q * SS_FIX + 0.5f)); }
        }
    }
};
struct EpiRowScale {
    static constexpr bool PERM = true;
    const unsigned long long* ss; bf16* out; int ldc; float scale;
    DI void operator()(const A4 (&acc)[2][2][4][2], const Unit& u, int wr, int wc, int fr, int fq) const {
        const int row0 = EPI_ROWS(u, wr, fr), c0 = u.pn * 256 + wc * 32 + 8 * fq;
#pragma unroll
        for (int ai = 0; ai < 2; ++ai)
#pragma unroll
            for (int m = 0; m < 4; ++m) { const int r = row0 + ai * 128 + m * 16; const float s = scale / sqrtf(ss_get(ss, r) * (1.0f / D) + EPS); const size_t ro = (size_t)r * ldc + c0;
#pragma unroll
                for (int bj = 0; bj < 2; ++bj) *(GAS v4u*)(out + ro + bj * 128) = pack8(acc[ai][bj][m][0] * s, acc[ai][bj][m][1] * s); }
    }
};

struct EpiQFrag {
    static constexpr bool PERM = true;
    const unsigned long long* ss; bf16* out; float scale;
    DI void operator()(const A4 (&acc)[2][2][4][2], const Unit& u, int wr, int wc, int fr, int fq) const {
        const int row0 = EPI_ROWS(u, wr, fr), cw = wc * 32 + 8 * fq;
#pragma unroll
        for (int ai = 0; ai < 2; ++ai)
#pragma unroll
            for (int m = 0; m < 4; ++m) { const int r = row0 + ai * 128 + m * 16;
#pragma unroll
                for (int bj = 0; bj < 2; ++bj) { const int c = cw + bj * 128;
                    *(GAS v4u*)(out + ((size_t)((((r >> 5) * 4 + u.pn) * 32 + (c >> 3)) * 32 + (r & 31))) * 8) = pack8(acc[ai][bj][m][0] * scale, acc[ai][bj][m][1] * scale); } }
    }
};

struct EpiPQFrag {
    static constexpr bool PERM = true;
    const unsigned long long* ss; bf16* out;
    DI void operator()(const A4 (&acc)[2][2][4][2], const Unit& u, int wr, int wc, int fr, int fq) const {
        const int row0 = EPI_ROWS(u, wr, fr), cw = wc * 32 + 8 * fq;
#pragma unroll
        for (int ai = 0; ai < 2; ++ai)
#pragma unroll
            for (int m = 0; m < 4; ++m) { const int r = row0 + ai * 128 + m * 16;
#pragma unroll
                for (int bj = 0; bj < 2; ++bj)
                    *(GAS v4u*)(out + ((size_t)((((((r >> 5) * 8 + u.pn) * 2 + bj) * 16 + (cw >> 3)) * 32) + (r & 31))) * 8) = pack8(acc[ai][bj][m][0], acc[ai][bj][m][1]); }
    }
};

DI void kv_gemm(const Args& a, const Ctx& F) {
    unsigned char* ws = a.ws;
    const float* rsm = (const float*)(ws + WS_RSM); bf16* kb = (bf16*)(ws + WS_KB); bf16* vt = (bf16*)(ws + WS_VT);
    LAS unsigned char* lds = F.lds + RING_OFF;
    const int lane = F.lane, wave = F.wave, wm = wave >> 2, wn = wave & 3, fr = lane & 15, fq = lane >> 4;
    const int R0 = 8 * wave + (lane >> 3), csrc = (lane & 7) ^ ((R0 >> 1) & 7);
    const unsigned goff = (unsigned)(R0 * D + 8 * csrc) * 2u;
    const int swz = (fr >> 1) & 7;
    const unsigned fo0 = (unsigned)((fq ^ swz) << 4), fo1 = (unsigned)(((4 + fq) ^ swz) << 4);
    const unsigned abase = (unsigned)((64 * wm + fr) * 128), bbase = 16384u + (unsigned)((32 * wn + fr) * 128);
#define KV_STAGE(st, kt) do { const char* pa_ = gA + (size_t)(kt) * 128 + goff; const char* pb_ = gB + (size_t)(kt) * 128 + goff; LAS unsigned char* sb_ = lds + (st) * 32768 + wave * 1024; \
        __builtin_amdgcn_global_load_lds((const unsigned*)pa_, (LAS unsigned*)sb_, 16, 0, 0); __builtin_amdgcn_global_load_lds((const unsigned*)(pa_ + 64 * D * 2), (LAS unsigned*)(sb_ + 8192), 16, 0, 0); \
        __builtin_amdgcn_global_load_lds((const unsigned*)pb_, (LAS unsigned*)(sb_ + 16384), 16, 0, 0); __builtin_amdgcn_global_load_lds((const unsigned*)(pb_ + 64 * D * 2), (LAS unsigned*)(sb_ + 24576), 16, 0, 0); } while (0)
    __builtin_amdgcn_s_waitcnt(0xF70);
    for (int tile = F.vcu; tile < 256; tile += F.G) {
        const int m0 = (tile >> 4) * 128, n0 = (tile & 15) * 128; const bool vpart = n0 >= 1024;
        const char* gA = (const char*)((const bf16*)a.out + (size_t)m0 * D); const char* gB = (const char*)((const bf16*)(ws + WS_WKV) + (size_t)n0 * D);
        pg8::f32x4 acc[4][2];
#pragma unroll
        for (int mi = 0; mi < 4; ++mi)
#pragma unroll
            for (int ni = 0; ni < 2; ++ni) acc[mi][ni] = (pg8::f32x4){0.f, 0.f, 0.f, 0.f};
        KV_STAGE(0, 0); KV_STAGE(1, 1); KV_STAGE(2, 2);
#pragma unroll 1
        for (int kt = 0; kt < 16; ++kt) {
            if (kt <= 13) __builtin_amdgcn_s_waitcnt(0xF78); else if (kt == 14) __builtin_amdgcn_s_waitcnt(0xF74); else __builtin_amdgcn_s_waitcnt(0xF70);
            asm volatile("" ::: "memory"); __builtin_amdgcn_s_barrier(); asm volatile("" ::: "memory");
            const LAS unsigned char* sb = lds + (kt & 3) * 32768;
            bf16x8 af[4][2], bfr[2][2];
#pragma unroll
            for (int mi = 0; mi < 4; ++mi) { af[mi][0] = *(const LAS bf16x8*)(sb + abase + mi * 2048 + fo0); af[mi][1] = *(const LAS bf16x8*)(sb + abase + mi * 2048 + fo1); }
#pragma unroll
            for (int ni = 0; ni < 2; ++ni) { bfr[ni][0] = *(const LAS bf16x8*)(sb + bbase + ni * 2048 + fo0); bfr[ni][1] = *(const LAS bf16x8*)(sb + bbase + ni * 2048 + fo1); }
            if (vpart) {
#pragma unroll
                for (int mi = 0; mi < 4; ++mi)
#pragma unroll
                    for (int ni = 0; ni < 2; ++ni)
#pragma unroll
                        for (int ks = 0; ks < 2; ++ks) acc[mi][ni] = __builtin_amdgcn_mfma_f32_16x16x32_bf16(af[mi][ks], bfr[ni][ks], acc[mi][ni], 0, 0, 0);
            } else {
#pragma unroll
                for (int mi = 0; mi < 4; ++mi)
#pragma unroll
                    for (int ni = 0; ni < 2; ++ni)
#pragma unroll
                        for (int ks = 0; ks < 2; ++ks) acc[mi][ni] = __builtin_amdgcn_mfma_f32_16x16x32_bf16(bfr[ni][ks], af[mi][ks], acc[mi][ni], 0, 0, 0);
            }
            __builtin_amdgcn_sched_barrier(0);
            if (kt + 3 < 16) KV_STAGE((kt + 3) & 3, kt + 3);
        }
        if (!vpart) {
#pragma unroll
            for (int mi = 0; mi < 4; ++mi) { const int m = m0 + 64 * wm + 16 * mi + fr; const float s = 1.0f;
#pragma unroll
                for (int ni = 0; ni < 2; ++ni) { const pg8::f32x4 v = acc[mi][ni] * s;
                    *(GAS v2u*)(kb + (size_t)m * D + n0 + 32 * wn + 16 * ni + 4 * fq) = (v2u){pk2(v[0], v[1]), pk2(v[2], v[3])}; } }
        } else {
#pragma unroll
            for (int mi = 0; mi < 4; ++mi) { const int mb = m0 + 64 * wm + 16 * mi, b = mb >> 8, key0 = mb & 255; const pg8::f32x4 s4 = (pg8::f32x4){1.f, 1.f, 1.f, 1.f};
#pragma unroll
                for (int ni = 0; ni < 2; ++ni) { const pg8::f32x4 v = acc[mi][ni] * s4; const int col = n0 - 1024 + 32 * wn + 16 * ni + fr;
                    *(GAS v2u*)(vt + (size_t)(b * 1024 + col) * 256 + key0 + 8 * (fq & 1) + 4 * (fq >> 1)) = (v2u){pk2(v[0], v[1]), pk2(v[2], v[3])}; } }
        }
        __builtin_amdgcn_s_waitcnt(0xF70);
        __syncthreads();
    }
#undef KV_STAGE
}

constexpr int TS = 16, RUNLEN = 128;
template <int K, int I> DI void conv_one(f32x2 (&acc)[TS], const f32x2 (&w)[31], const f32x2 x) { if constexpr (K - I >= 0 && K - I <= 30) acc[I] += w[K - I] * x; }
template <int K, int... Is> DI void conv_row(f32x2 (&acc)[TS], const f32x2 (&w)[31], const f32x2 x, std::integer_sequence<int, Is...>) { (conv_one<K, Is>(acc, w, x), ...); }
template <int... Ks> DI void conv_all(f32x2 (&acc)[TS], const f32x2 (&w)[31], const unsigned (&win)[TS + 30], std::integer_sequence<int, Ks...>) {
    (conv_row<Ks>(acc, w, (f32x2){bflo(win[Ks]), bfhi(win[Ks])}, std::make_integer_sequence<int, TS>{}), ...); }
DI void conv_phase(const Args& a, const Ctx& F) {
    unsigned char* ws = a.ws;
    const GAS unsigned* SCB = (const GAS unsigned*)(ws + WS_S1); const GAS unsigned* CX = (const GAS unsigned*)(ws + WS_S2); const GAS unsigned* GLU = (const GAS unsigned*)(ws + WS_S3);
    GAS unsigned* YSC = (GAS unsigned*)a.out; GAS unsigned* CFA = (GAS unsigned*)((unsigned char*)a.out + 64 * MiB);
    const int tid = F.tid, lane = F.lane, wave = F.wave;
    LAS float* red = (LAS float*)(F.lds + RING_OFF);
    f32x2 w31[31];
#pragma unroll
    for (int j = 0; j < 31; ++j) w31[j] = *(const f32x2*)(a.in[I_CFCW] + j * D + 2 * tid);
    const f32x2 w3a = *(const f32x2*)(a.in[I_SCCW] + 2 * tid), w3b = *(const f32x2*)(a.in[I_SCCW] + D + 2 * tid), w3c = *(const f32x2*)(a.in[I_SCCW] + 2 * D + 2 * tid);
    const f32x2 cb = *(const f32x2*)(a.in[I_CFCB] + 2 * tid), lg = *(const f32x2*)(a.in[I_LNG] + 2 * tid), lb = *(const f32x2*)(a.in[I_LNB] + 2 * tid);
    for (int run = F.vcu; run < T / RUNLEN; run += F.G) {
        const int t0 = run * RUNLEN; const bool first = (t0 & (SEQ - 1)) == 0; const unsigned hmask = first ? 0u : 0xffffffffu;
        unsigned win[TS + 30], gn[TS], cs[TS], sb[TS];
#pragma unroll
        for (int k = 0; k < TS + 30; ++k) { const int row = (k < 30 && first) ? t0 : t0 - 30 + k; const unsigned w = GLU[(size_t)row * 512 + tid]; win[k] = (k < 30) ? (w & hmask) : w; }
        const int rh = first ? t0 : t0 - 2;
        unsigned c0 = CX[(size_t)rh * 512 + tid] & hmask, c1 = CX[(size_t)(rh + (first ? 0 : 1)) * 512 + tid] & hmask;
#pragma unroll
        for (int k = 0; k < TS; ++k) { cs[k] = CX[(size_t)(t0 + k) * 512 + tid]; sb[k] = SCB[(size_t)(t0 + k) * 512 + tid]; }
#pragma unroll
        for (int k = 0; k < TS; ++k) gn[k] = GLU[(size_t)(t0 + TS + k) * 512 + tid];
#pragma unroll 1
        for (int s = 0; s < RUNLEN / TS; ++s) {
            const int ts = t0 + s * TS;
            f32x2 acc[TS];
#pragma unroll
            for (int i = 0; i < TS; ++i) acc[i] = cb;
            conv_all(acc, w31, win, std::make_integer_sequence<int, TS + 30>{});
#pragma unroll
            for (int k = 0; k < 30; ++k) win[k] = win[k + TS];
#pragma unroll
            for (int k = 0; k < TS; ++k) win[30 + k] = gn[k];
            if (s + 2 < RUNLEN / TS) {
#pragma unroll
                for (int k = 0; k < TS; ++k) gn[k] = GLU[(size_t)(ts + 2 * TS + k) * 512 + tid];
            }
            float v[32];
#pragma unroll
            for (int i = 0; i < TS; ++i) { const f32x2 x = acc[i]; v[i] = x.x + x.y; v[16 + i] = x.x * x.x + x.y * x.y; }
            const float r = treduce<32, 5>(v, lane);
            LAS float* rb = red + (s & 1) * 256;
            if ((lane & 1) == 0) rb[wave * 32 + (lane >> 1)] = r;
            LDS_WAIT(); __builtin_amdgcn_s_barrier(); asm volatile("" ::: "memory");
            float tot = 0.f;
#pragma unroll
            for (int w = 0; w < 8; ++w) tot += rb[w * 32 + (lane & 31)];
#pragma unroll
            for (int i = 0; i < TS; ++i) {
                const float mean = __builtin_bit_cast(float, __builtin_amdgcn_readlane(__builtin_bit_cast(int, tot), i)) * (1.0f / D);
                const float ex2 = __builtin_bit_cast(float, __builtin_amdgcn_readlane(__builtin_bit_cast(int, tot), 16 + i)) * (1.0f / D);
                const float rstd = 1.0f / sqrtf(fmaxf(ex2 - mean * mean, 0.f) + EPS);
                const f32x2 y = (acc[i] - mean) * rstd * lg + lb;
                const float o0 = y.x * sigmoidf_(y.x), o1 = y.y * sigmoidf_(y.y);
                CFA[(size_t)(ts + i) * 512 + tid] = pk2(o0, o1);
            }
#pragma unroll
            for (int i = 0; i < TS; ++i) {
                const unsigned c2 = cs[i];
                const f32x2 x0 = (f32x2){bflo(c0), bfhi(c0)}, x1 = (f32x2){bflo(c1), bfhi(c1)}, x2 = (f32x2){bflo(c2), bfhi(c2)};
                const f32x2 cv = w3a * x0 + w3b * x1 + w3c * x2;
                YSC[(size_t)(ts + i) * 512 + tid] = pk2(bflo(sb[i]) * cv.x, bfhi(sb[i]) * cv.y);
                c0 = c1; c1 = c2;
            }
            if (s + 1 < RUNLEN / TS) {
#pragma unroll
                for (int k = 0; k < TS; ++k) { cs[k] = CX[(size_t)(ts + TS + k) * 512 + tid]; sb[k] = SCB[(size_t)(ts + TS + k) * 512 + tid]; }
            }
        }
    }
}

typedef _Float16 h2_t __attribute__((ext_vector_type(2)));
#define MFMA32(a, b, c) __builtin_amdgcn_mfma_f32_32x32x16_bf16((a), (b), (c), 0, 0, 0)
DI int crow(int reg, int h) { return (reg & 3) + 8 * (reg >> 2) + 4 * h; }
DI bf16x8 pack_frag(const f32x16& x, int s) {
    v4u p; p.x = pk2(x[8 * s + 0], x[8 * s + 1]); p.y = pk2(x[8 * s + 2], x[8 * s + 3]); p.z = pk2(x[8 * s + 4], x[8 * s + 5]); p.w = pk2(x[8 * s + 6], x[8 * s + 7]);
    return __builtin_bit_cast(bf16x8, p);
}
template <int I0, int N> DI void attn_stage_load(v4u (&tmp)[16], const bf16* src, size_t row_stride, int tid) {
    const unsigned off0 = (unsigned)(((tid >> 5) * (int)row_stride + 8 * (tid & 31)) * 2);
#pragma unroll
    for (int i = I0; i < I0 + N; ++i) tmp[i] = *(const GAS v4u*)((const GAS char*)src + (size_t)i * 32 * row_stride + off0);
}
template <int I0, int N> DI void attn_stage_store(LAS unsigned char* kl, const v4u (&tmp)[16], int tid) {
#pragma unroll
    for (int i = I0; i < I0 + N; ++i) { const int id = tid + 512 * i, row = id >> 5, c = id & 31; *(LAS v4u*)(kl + row * 512 + ((c ^ (row & 15)) << 4)) = tmp[i]; }
    asm volatile("" ::: "memory");
}
DI void attn_phase(const Args& a, const Ctx& F) {
    unsigned char* ws = a.ws;
    const bf16* QB = (const bf16*)(ws + WS_S3); const bf16* KB = (const bf16*)(ws + WS_KB); const bf16* VT = (const bf16*)(ws + WS_VT); bf16* OB = (bf16*)(ws + WS_S4);
    const int lane = F.lane, r = lane & 31, hh = lane >> 5;
    LAS unsigned char* kl = F.lds + RING_OFF;
    LAS unsigned char* ot = F.lds + ZACC_OFF + F.wave * 2560;
    pg8::StaticOrder SO; SO.init(T, D, F.G, (int)blockIdx.x);
    pg8::Unit cu, nu; bool have = SO.next(0, cu);
    v4u st[16];
    if (have) attn_stage_load<0, 16>(st, KB + (size_t)((cu.pm >> 4) * NMEM) * D + cu.pn * 256, D, F.tid);
    for (int ui = 0; have; ++ui) {
        const bool hasn = SO.next(ui + 1, nu);
        const int b = cu.pm >> 4, h = cu.pn, qt = cu.pm & 15;
        const int t0 = b * SEQ + qt * 256 + F.wave * 32;
        const bf16* qp = QB + ((size_t)(((t0 >> 5) * 4 + h) * 32 + hh) * 32 + r) * 8;
        bf16x8 qf[16];
#pragma unroll
        for (int kk = 0; kk < 16; ++kk) qf[kk] = *(const GAS bf16x8*)(qp + 512 * kk);
        __syncthreads();
        attn_stage_store<0, 16>(kl, st, F.tid);
        attn_stage_load<0, 8>(st, VT + (size_t)(b * 1024 + h * 256) * 256, 256, F.tid);
        __syncthreads();
        const int sw = r & 15;
        const LAS unsigned char* kb0 = kl + r * 512 + ((hh ^ (sw & 1)) << 4); const int kc = sw >> 1;
#define KBASE(k7) (kb0 + (((k7) ^ kc) << 5))
        float mx = -3.0e38f;
        h2_t s16[8][8];
#pragma unroll
        for (int kb = 0; kb < 8; ++kb) {
            f32x16 acc;
#pragma unroll
            for (int i = 0; i < 16; ++i) acc[i] = 0.f;
#pragma unroll
            for (int kk = 0; kk < 16; ++kk) { const bf16x8 kf = *(const LAS bf16x8*)(KBASE(kk & 7) + kb * 16384 + (kk >> 3) * 256); acc = MFMA32(kf, qf[kk], acc); if ((kk & 7) == 7) asm volatile("" ::: "memory"); }
#pragma unroll
            for (int i = 0; i < 16; ++i) mx = __builtin_fmaxf(mx, acc[i]);
#pragma unroll
            for (int j = 0; j < 8; ++j) s16[kb][j] = __builtin_convertvector((f32x2){acc[2 * j], acc[2 * j + 1]}, h2_t);
        }
        mx = __builtin_fmaxf(mx, __shfl_xor(mx, 32));
        const float qs = 1.0f / sqrtf(ss_get((const unsigned long long*)(ws + WS_SS1), t0 + r) * (1.0f / D) + EPS);
        attn_stage_load<8, 8>(st, VT + (size_t)(b * 1024 + h * 256) * 256, 256, F.tid);
        float l = 0.f;
        bf16x8 pf[8][2];
#pragma unroll
        for (int kb = 0; kb < 8; ++kb) {
            f32x16 acc;
#pragma unroll
            for (int j = 0; j < 8; ++j) { const f32x2 sv = __builtin_convertvector(s16[kb][j], f32x2);
                const float p0 = __builtin_amdgcn_exp2f((sv.x - mx) * qs), p1 = __builtin_amdgcn_exp2f((sv.y - mx) * qs); acc[2 * j] = p0; acc[2 * j + 1] = p1; l += p0 + p1; }
            pf[kb][0] = pack_frag(acc, 0); pf[kb][1] = pack_frag(acc, 1);
        }
        l += __shfl_xor(l, 32);
        const float inv = 1.0f / l;
        __syncthreads();
        attn_stage_store<0, 16>(kl, st, F.tid);
        if (hasn) attn_stage_load<0, 16>(st, KB + (size_t)((nu.pm >> 4) * NMEM) * D + nu.pn * 256, D, F.tid);
        __syncthreads();
        int r2 = r; asm volatile("" : "+v"(r2));
        const LAS unsigned char* vbase[8];
#pragma unroll
        for (int k7 = 0; k7 < 8; ++k7) vbase[k7] = kl + r2 * 512 + (((4 * (k7 >> 1) + 2 * (k7 & 1) + hh) ^ (r2 & 15)) << 4);
        bf16* op = OB + (size_t)t0 * D + h * 256;
#pragma unroll 1
        for (int db = 0; db < 8; ++db) {
            f32x16 acc;
#pragma unroll
            for (int i = 0; i < 16; ++i) acc[i] = 0.f;
#pragma unroll
            for (int kb = 0; kb < 8; ++kb)
#pragma unroll
                for (int s = 0; s < 2; ++s) { const bf16x8 vf = *(const LAS bf16x8*)(vbase[(kb & 3) * 2 + s] + db * 16384 + (kb >> 2) * 256); acc = MFMA32(vf, pf[kb][s], acc); if (s == 1 && (kb & 3) == 3) asm volatile("" ::: "memory"); }
#pragma unroll
            for (int g = 0; g < 4; ++g) { v2u w; w.x = pk2(acc[4 * g] * inv, acc[4 * g + 1] * inv); w.y = pk2(acc[4 * g + 2] * inv, acc[4 * g + 3] * inv);
                *(LAS v2u*)(ot + r * 80 + 16 * g + 8 * hh) = w; }
#pragma unroll
            for (int q = 0; q < 2; ++q) { const int row = (lane >> 2) + 16 * q; const v4u w = *(const LAS v4u*)(ot + row * 80 + 16 * (lane & 3));
                *(GAS v4u*)(op + (size_t)row * D + 32 * db + 8 * (lane & 3)) = w; }
        }
        have = hasn; cu = nu;
    }
#undef KBASE
}

template <int N, int LOGN> DI void bsort_desc(float (&v)[N]) {
#pragma unroll
    for (int ks = 1; ks <= LOGN; ++ks) {
#pragma unroll
        for (int js = ks - 1; js >= 0; --js) {
#pragma unroll
            for (int i = 0; i < N; ++i) {
                const int j = 1 << js, k = 1 << ks, l = i ^ j;
                if (l > i) { const bool up = (i & k) != 0 && ks < LOGN; const float x = v[i], y = v[l]; const float hi = fmax_(x, y), lo = fmin_(x, y); v[i] = up ? lo : hi; v[l] = up ? hi : lo; }
            }
        }
    }
}
DI void merge_top16(float (&a)[16], const float (&b)[16]) {
#pragma unroll
    for (int i = 0; i < 16; ++i) a[i] = fmax_(a[i], b[15 - i]);
#pragma unroll
    for (int js = 3; js >= 0; --js) {
#pragma unroll
        for (int i = 0; i < 16; ++i) { const int j = 1 << js, l = i ^ j; if (l > i) { const float x = a[i], y = a[l]; a[i] = fmax_(x, y); a[l] = fmin_(x, y); } }
    }
}
DI float embed_lo(float v, unsigned mask, unsigned payload) { return __builtin_bit_cast(float, (__builtin_bit_cast(unsigned, v) & ~mask) | payload); }
#define SN_CE(i, j) { const float x_ = v[i], y_ = v[j]; v[i] = fmax_(x_, y_); v[j] = fmin_(x_, y_); }
DI void sort16_desc(float (&v)[16]) {
    SN_CE(0, 13) SN_CE(1, 12) SN_CE(2, 15) SN_CE(3, 14) SN_CE(4, 8) SN_CE(5, 6) SN_CE(7, 11) SN_CE(9, 10)
    SN_CE(0, 5) SN_CE(1, 7) SN_CE(2, 9) SN_CE(3, 4) SN_CE(6, 13) SN_CE(8, 14) SN_CE(10, 15) SN_CE(11, 12)
    SN_CE(0, 1) SN_CE(2, 3) SN_CE(4, 5) SN_CE(6, 8) SN_CE(7, 9) SN_CE(10, 11) SN_CE(12, 13) SN_CE(14, 15)
    SN_CE(0, 2) SN_CE(1, 3) SN_CE(4, 10) SN_CE(5, 11) SN_CE(6, 7) SN_CE(8, 9) SN_CE(12, 14) SN_CE(13, 15)
    SN_CE(1, 2) SN_CE(3, 12) SN_CE(4, 6) SN_CE(5, 7) SN_CE(8, 10) SN_CE(9, 11) SN_CE(13, 14)
    SN_CE(1, 4) SN_CE(2, 6) SN_CE(5, 8) SN_CE(7, 10) SN_CE(9, 13) SN_CE(11, 14)
    SN_CE(2, 4) SN_CE(3, 6) SN_CE(9, 12) SN_CE(11, 13)
    SN_CE(3, 5) SN_CE(6, 8) SN_CE(7, 9) SN_CE(10, 12)
    SN_CE(3, 4) SN_CE(5, 6) SN_CE(7, 8) SN_CE(9, 10) SN_CE(11, 12)
    SN_CE(6, 7) SN_CE(8, 9)
}
#undef SN_CE
DI void sub_top16h(float (&top)[16], const bf16* qrow, const LAS unsigned char* skl, int r, int hh) {
    bf16x8 qf[8];
#pragma unroll
    for (int kk = 0; kk < 8; ++kk) qf[kk] = *(const GAS bf16x8*)(qrow + 512 * kk);
#pragma unroll
    for (int i = 0; i < 16; ++i) top[i] = -3.0e38f;
#pragma unroll 1
    for (int kb = 0; kb < 4; ++kb) {
        f32x16 acc;
#pragma unroll
        for (int i = 0; i < 16; ++i) acc[i] = 0.f;
        const int row = 32 * kb + r;
#pragma unroll
        for (int kk = 0; kk < 8; ++kk) { const bf16x8 sf = *(const LAS bf16x8*)(skl + row * 256 + (((2 * kk + hh) ^ (row & 15)) << 4)); acc = MFMA32(sf, qf[kk], acc); }
        float g[16];
#pragma unroll
        for (int i = 0; i < 16; ++i) g[i] = embed_lo(acc[i], 127u, (unsigned)(32 * kb + crow(i, hh)));
        sort16_desc(g);
        if (kb == 0) {
#pragma unroll
            for (int i = 0; i < 16; ++i) top[i] = g[i];
        } else merge_top16(top, g);
    }
}
DI void sub_top16_pair(float (&s)[16], const bf16* qA, const bf16* qB, const LAS unsigned char* skl, int r, int hh) {
    float ta[16], tb[16];
    sub_top16h(ta, qA, skl, r, hh);
    sub_top16h(tb, qB, skl, r, hh);
    float o[16];
#pragma unroll
    for (int i = 0; i < 16; ++i) { const float mine = hh ? tb[i] : ta[i], give = hh ? ta[i] : tb[i]; o[i] = __shfl_xor(give, 32); s[i] = mine; }
    merge_top16(s, o);
}
DI void route_phase(const Args& a, const Ctx& F) {
    unsigned char* ws = a.ws;
    const bf16* PQ = (const bf16*)a.out; const bf16* SKB = (const bf16*)(ws + WS_SKB);
    int* EIDX = (int*)(ws + WS_S0); float* GATE = (float*)(ws + WS_S0 + 16 * MiB);
    const int lane = F.lane, r = lane & 31, hh = lane >> 5;
    LAS unsigned* T1 = (LAS unsigned*)(F.lds + RING_OFF + F.wave * 8192);
    LAS unsigned* T2 = T1 + 1024;
    LAS unsigned char* skl = F.lds + RING_OFF + 65536;
    for (int id = F.tid; id < 4096; id += NWAVES * 64) { const int row = id >> 4, c = id & 15;
        *(LAS v4u*)(skl + row * 256 + ((c ^ (row & 15)) << 4)) = *(const GAS v4u*)(SKB + (size_t)id * 8); }
    __syncthreads();
    const int gw = F.vcu * NWAVES + F.wave, NGW = F.G * NWAVES;
    for (int dt = gw; dt < T / 8; dt += NGW) {
        const int blk = dt >> 2, head = 2 * (dt & 3) + hh;
        const float rsl = LOG2E / sqrtf(ss_get((const unsigned long long*)(ws + WS_SS2), blk * 32 + r) * (1.0f / D) + EPS);
        const bf16* qA = PQ + ((size_t)(blk * 8 + 2 * (dt & 3)) * 2 * 16 * 32 + hh * 32 + r) * 8; const bf16* qB = qA + 2 * 16 * 32 * 8;
        float sa[16], sb[16];
        sub_top16_pair(sa, qA, qB, skl, r, hh);
        sub_top16_pair(sb, qA + 16 * 32 * 8, qB + 16 * 32 * 8, skl + 32768, r, hh);
#pragma unroll
        for (int i = 0; i < 16; ++i) { T1[i * 64 + lane] = __builtin_bit_cast(unsigned, sa[i]) & 127u; T2[i * 64 + lane] = __builtin_bit_cast(unsigned, sb[i]) & 127u; }
        float tc[16];
#define CAND(A, B) embed_lo(sa[A] + sb[B], 255u, (unsigned)(((A) << 4) | (B)))
        {
#pragma unroll
            for (int i = 0; i < 16; ++i) tc[i] = CAND(0, i);
            float c[16];
#pragma unroll
            for (int i = 0; i < 8; ++i) c[i] = CAND(1, i);
#pragma unroll
            for (int i = 0; i < 5; ++i) c[8 + i] = CAND(2, i);
#pragma unroll
            for (int i = 0; i < 3; ++i) c[13 + i] = CAND(3, i);
            sort16_desc(c); merge_top16(tc, c);
            c[0] = CAND(3, 3);
#pragma unroll
            for (int i = 0; i < 3; ++i) c[1 + i] = CAND(4, i);
#pragma unroll
            for (int i = 0; i < 2; ++i) { c[4 + i] = CAND(5, i); c[6 + i] = CAND(6, i); c[8 + i] = CAND(7, i); }
#pragma unroll
            for (int i = 0; i < 6; ++i) c[10 + i] = CAND(8 + i, 0);
            sort16_desc(c); merge_top16(tc, c);
            const float x = CAND(14, 0), y = CAND(15, 0);
            c[0] = fmax_(x, y); c[1] = fmin_(x, y);
#pragma unroll
            for (int i = 2; i < 16; ++i) c[i] = -3.0e38f;
            merge_top16(tc, c);
        }
#undef CAND
        float wgt[16]; float sum = 0.f;
#pragma unroll
        for (int i = 0; i < 16; ++i) { wgt[i] = __builtin_amdgcn_exp2f((tc[i] - tc[0]) * rsl); sum += wgt[i]; }
        const float inv = 1.0f / sum;
        int e[16];
#pragma unroll
        for (int i = 0; i < 16; ++i) { const unsigned bits = __builtin_bit_cast(unsigned, tc[i]); const unsigned ia = (bits >> 4) & 15u, ib = bits & 15u;
            e[i] = (int)(T1[ia * 64 + lane] * 128u + T2[ib * 64 + lane]); wgt[i] *= inv; }
        {
            const int tok = blk * 32 + r;
            GAS v4u* ep = (GAS v4u*)((unsigned short*)EIDX + (size_t)tok * 128 + head * 16); GAS f32x4* gp = (GAS f32x4*)(GATE + (size_t)tok * 128 + head * 16);
#pragma unroll
            for (int q = 0; q < 2; ++q) ep[q] = (v4u){(unsigned)e[8 * q] | ((unsigned)e[8 * q + 1] << 16), (unsigned)e[8 * q + 2] | ((unsigned)e[8 * q + 3] << 16),
                                                      (unsigned)e[8 * q + 4] | ((unsigned)e[8 * q + 5] << 16), (unsigned)e[8 * q + 6] | ((unsigned)e[8 * q + 7] << 16)};
#pragma unroll
            for (int q = 0; q < 4; ++q) gp[q] = (f32x4){wgt[4 * q], wgt[4 * q + 1], wgt[4 * q + 2], wgt[4 * q + 3]};
        }
    }
}

DI void unpack16(const v4u xa, const v4u xb, f32x2 (&h)[8]) {
    h[0] = (f32x2){bflo(xa[0]), bfhi(xa[0])}; h[1] = (f32x2){bflo(xa[1]), bfhi(xa[1])}; h[2] = (f32x2){bflo(xa[2]), bfhi(xa[2])}; h[3] = (f32x2){bflo(xa[3]), bfhi(xa[3])};
    h[4] = (f32x2){bflo(xb[0]), bfhi(xb[0])}; h[5] = (f32x2){bflo(xb[1]), bfhi(xb[1])}; h[6] = (f32x2){bflo(xb[2]), bfhi(xb[2])}; h[7] = (f32x2){bflo(xb[3]), bfhi(xb[3])};
}
DI float dot16_fp8(const f32x2 (&h)[8], const v4u r) {
    f32x2 acc = (f32x2){0.f, 0.f};
#pragma unroll
    for (int w = 0; w < 4; ++w) { const int rw = (int)r[w]; acc += h[2 * w] * __builtin_amdgcn_cvt_pk_f32_fp8(rw, false); acc += h[2 * w + 1] * __builtin_amdgcn_cvt_pk_f32_fp8(rw, true); }
    return acc.x + acc.y;
}
struct PeBuf { v4u row[16]; v4u xa, xb; };
DI void pe_ids(unsigned (&e)[8], const int* EIDX, int tok, int g) {
    const GAS v4u* p = (const GAS v4u*)((const unsigned short*)EIDX + (size_t)tok * 128 + 16 * g);
#pragma unroll
    for (int q = 0; q < 2; ++q) { const v4u w = p[q]; e[4 * q] = w[0]; e[4 * q + 1] = w[1]; e[4 * q + 2] = w[2]; e[4 * q + 3] = w[3]; }
}
#define PE_ID(e, i) (((i) & 1) ? ((e)[(i) >> 1] >> 16) : ((e)[(i) >> 1] & 0xffffu))
DI void peer_u_phase(const Args& a, const Ctx& F) {
    unsigned char* ws = a.ws;
    const bf16* X2 = (const bf16*)(ws + WS_S5); const int* EIDX = (const int*)(ws + WS_S0);
    const unsigned long long* SS2 = (const unsigned long long*)(ws + WS_SS2);
    const float* GATE = (const float*)(ws + WS_S0 + 16 * MiB); unsigned char* ACT = ws + WS_S0 + 32 * MiB;
    const int lane = F.lane, j = F.xj, g = lane >> 3, seg = lane & 7, r = lane & 15, kq = lane >> 4;
    const int wq = F.xrank * NWAVES + F.wave, NWQ = F.xn * NWAVES;
    const unsigned char* UB = (const unsigned char*)(ws + WS_UB);
    LAS unsigned char* img = F.lds + RING_OFF + F.wave * 16384;
    LAS unsigned char* xl = F.lds + LDSCTL_OFF + 1024 + F.wave * 256;
    LAS _Float16* zacc = (LAS _Float16*)(F.lds + ZACC_OFF + F.wave * 3584);
    unsigned wro[2];
#pragma unroll
    for (int b = 0; b < 2; ++b) { const int rr = 2 * g + b; wro[b] = (unsigned)(rr * 128 + ((seg ^ (rr & 7)) << 4)); }
    unsigned rdo[2];
#pragma unroll
    for (int s = 0; s < 2; ++s) rdo[s] = (unsigned)(r * 128 + (((4 * s + kq) ^ (r & 7)) << 4));
    constexpr int NCLS = T / 8;
    const int nk = wq < NCLS ? (NCLS - wq + NWQ - 1) / NWQ : 0;
    const int nit = 4 * nk;
    if (nit == 0) return;
    unsigned e[8]; v4u R[16]; v2u xw; v4u zx = (v4u){0u, 0u, 0u, 0u}, zy = zx;
#define PU_DECODE(it, tok_, sl_, s_, tb_) const int b_##tok_ = (it) >> 6, rem_##tok_ = (it) & 63, nb_##tok_ = (nk - 16 * b_##tok_) < 16 ? (nk - 16 * b_##tok_) : 16; \
        const int s_ = nb_##tok_ == 16 ? rem_##tok_ >> 4 : rem_##tok_ / nb_##tok_, tb_ = rem_##tok_ - s_ * nb_##tok_; \
        const int tok_ = 8 * (wq + (16 * b_##tok_ + tb_) * NWQ) + j, sl_ = (j + s_) & 3
#define PU_ISSUE(tok_, sl_) do { const unsigned char* US_ = UB + (size_t)(sl_) * NEXP * 128; _Pragma("unroll") for (int i = 0; i < 16; ++i) R[i] = *(const GAS v4u*)(US_ + (size_t)PE_ID(e, i) * 128 + 16 * seg); \
        xw = *(const GAS v2u*)(X2 + (size_t)(tok_) * D + 256 * (sl_) + 4 * lane); } while (0)
    { PU_DECODE(0, tk0, sl0, s0, tb0); pe_ids(e, EIDX, tk0, g); PU_ISSUE(tk0, sl0); }
    if (1 < nit) { PU_DECODE(1, tk1, sl1, s1, tb1); pe_ids(e, EIDX, tk1, g); }
    for (int it = 0; it < nit; ++it) {
        PU_DECODE(it, tok, sl, s, tb);
#pragma unroll
        for (int i = 0; i < 16; ++i) *(LAS v4u*)(img + (i & 7) * 2048 + wro[i >> 3]) = R[i];
        { int w = 0; const unsigned x0 = xw[0], x1 = xw[1];
          w = __builtin_amdgcn_cvt_pk_fp8_f32(bflo(x0), bfhi(x0), w, false); w = __builtin_amdgcn_cvt_pk_fp8_f32(bflo(x1), bfhi(x1), w, true); *(LAS unsigned*)(xl + 4 * lane) = (unsigned)w; }
        asm volatile("" ::: "memory");
        if (it + 1 < nit) { PU_DECODE(it + 1, tkn, sln, sn, tbn); PU_ISSUE(tkn, sln); }
        if (it + 2 < nit) { PU_DECODE(it + 2, tkm, slm, sm, tbm); pe_ids(e, EIDX, tkm, g); }
        __builtin_amdgcn_sched_barrier(0);
        i32x8 xb[2];
#pragma unroll
        for (int s2 = 0; s2 < 2; ++s2) { const i32x4 lo = *(const LAS i32x4*)(xl + 128 * s2 + 16 * kq), hi = *(const LAS i32x4*)(xl + 128 * s2 + 64 + 16 * kq); xb[s2] = __builtin_shufflevector(lo, hi, 0, 1, 2, 3, 4, 5, 6, 7); }
        float zr[8];
        i32x4 ar[4];
        ar[0] = *(const LAS i32x4*)(img + rdo[0]); ar[1] = *(const LAS i32x4*)(img + rdo[1]);
        __builtin_amdgcn_sched_group_barrier(0x100, 6, 0);
#pragma unroll
        for (int tl = 0; tl < 8; ++tl) {
            const i32x4 a0 = ar[(2 * tl) & 3], a1 = ar[(2 * tl + 1) & 3];
            if (tl + 1 < 8) { ar[(2 * tl + 2) & 3] = *(const LAS i32x4*)(img + (tl + 1) * 2048 + rdo[0]); ar[(2 * tl + 3) & 3] = *(const LAS i32x4*)(img + (tl + 1) * 2048 + rdo[1]); }
            const pg8::f32x4 zz = (pg8::f32x4){0.f, 0.f, 0.f, 0.f};
            const pg8::f32x4 z0 = __builtin_amdgcn_mfma_scale_f32_16x16x128_f8f6f4(__builtin_shufflevector(a0, a0, 0, 1, 2, 3, 4, 5, 6, 7), xb[0], zz, 4  , 0  , 0, 0x7f7f7f7f, 0, 0x7f7f7f7f);
            const pg8::f32x4 z1 = __builtin_amdgcn_mfma_scale_f32_16x16x128_f8f6f4(__builtin_shufflevector(a1, a1, 0, 1, 2, 3, 4, 5, 6, 7), xb[1], zz, 4  , 0  , 0, 0x7f7f7f7f, 0, 0x7f7f7f7f);
            __builtin_amdgcn_sched_group_barrier(0x100, 2, 0); __builtin_amdgcn_sched_group_barrier(0x8, 2, 0);
            const int n4 = r & 3;
            zr[tl] = (n4 == 0 ? z0[0] : n4 == 1 ? z0[1] : n4 == 2 ? z0[2] : z0[3]) + (n4 == 0 ? z1[0] : n4 == 1 ? z1[1] : n4 == 2 ? z1[2] : z1[3]);
        }
        if (r < 4) { const int rr = 4 * kq + r, slot = 16 * (rr >> 1) + 8 * (rr & 1);
            LAS v4u* zp = (LAS v4u*)(zacc + (tb < 14 ? tb : 0) * 128 + slot);
            if (s > 0) { const v4u pw = tb < 14 ? zp[0] : tb == 14 ? zx : zy;
#pragma unroll
                for (int q = 0; q < 4; ++q) { const unsigned w = pw[q]; const h2_t hv = __builtin_bit_cast(h2_t, w); zr[2 * q] += (float)hv.x; zr[2 * q + 1] += (float)hv.y; } }
            if (s < 3) { v4u o;
#pragma unroll
                for (int q = 0; q < 4; ++q) { const h2_t hv = (h2_t){(_Float16)zr[2 * q], (_Float16)zr[2 * q + 1]}; o[q] = __builtin_bit_cast(unsigned, hv); }
                if (tb < 14) zp[0] = o; else if (tb == 14) zx = o; else zy = o; }
            else {
                const float rs = (1.0f / U_SCALE) / sqrtf(ss_get(SS2, tok) * (1.0f / D) + EPS);
                const GAS f32x4* gp = (const GAS f32x4*)(GATE + (size_t)tok * 128 + slot);
                const f32x4 g0 = gp[0], g1 = gp[1]; f32x4 o0, o1;
#pragma unroll
                for (int c = 0; c < 4; ++c) { const float v0 = zr[c] * rs, v1 = zr[4 + c] * rs;
                    o0[c] = 0.5f * v0 * (1.0f + erff(v0 * 0.70710678118654752f)) * g0[c]; o1[c] = 0.5f * v1 * (1.0f + erff(v1 * 0.70710678118654752f)) * g1[c]; }
                int w0 = 0, w1 = 0;
                w0 = __builtin_amdgcn_cvt_pk_fp8_f32(o0[0] * A_SCALE, o0[1] * A_SCALE, w0, false); w0 = __builtin_amdgcn_cvt_pk_fp8_f32(o0[2] * A_SCALE, o0[3] * A_SCALE, w0, true);
                w1 = __builtin_amdgcn_cvt_pk_fp8_f32(o1[0] * A_SCALE, o1[1] * A_SCALE, w1, false); w1 = __builtin_amdgcn_cvt_pk_fp8_f32(o1[2] * A_SCALE, o1[3] * A_SCALE, w1, true);
                *(GAS v2u*)(ACT + (size_t)tok * 128 + slot) = (v2u){(unsigned)w0, (unsigned)w1};
            }
        }
        asm volatile("" ::: "memory");
    }
#undef PU_ISSUE
#undef PU_DECODE
}
DI void peer_act_phase(const Args& a, const Ctx& F) {
    unsigned char* ws = a.ws;
    const unsigned long long* SS2 = (const unsigned long long*)(ws + WS_SS2); const GAS v2u* ZP = (const GAS v2u*)(ws + WS_S1);
    const GAS f32x4* GATE = (const GAS f32x4*)(ws + WS_S0 + 16 * MiB); GAS f32x4* ACT = (GAS f32x4*)(ws + WS_S0 + 32 * MiB);
    const int gt = F.vcu * (NWAVES * 64) + F.tid, NGT = F.G * NWAVES * 64;
    for (int i = gt; i < T * 32; i += NGT) {
        f32x4 z = (f32x4){0.f, 0.f, 0.f, 0.f};
#pragma unroll
        for (int l = 0; l < 4; ++l) { const v2u w = ZP[(size_t)l * T * 32 + i]; const unsigned w0 = w[0], w1 = w[1];
            const h2_t p0 = __builtin_bit_cast(h2_t, w0), p1 = __builtin_bit_cast(h2_t, w1);
            z += (f32x4){(float)p0.x, (float)p0.y, (float)p1.x, (float)p1.y}; }
        const float rs = (1.0f / U_SCALE) / sqrtf(ss_get(SS2, i >> 5) * (1.0f / D) + EPS);
        const f32x4 gte = GATE[i]; f32x4 o;
#pragma unroll
        for (int c = 0; c < 4; ++c) { const float v = z[c] * rs; o[c] = 0.5f * v * (1.0f + erff(v * 0.70710678118654752f)) * gte[c]; }
        ACT[i] = o;
    }
}
DI void peer_v_phase(const Args& a, const Ctx& F) {
    unsigned char* ws = a.ws;
    const bf16* X2 = (const bf16*)(ws + WS_S5); bf16* X3 = (bf16*)(ws + WS_S3);
    const int* EIDX = (const int*)(ws + WS_S0); const unsigned char* ACT = ws + WS_S0 + 32 * MiB;
    const int lane = F.lane, j = F.xj, g = lane >> 3, seg = lane & 7, r = lane & 15, kq = lane >> 4;
    const int wq = F.xrank * NWAVES + F.wave, NWQ = F.xn * NWAVES;
    const unsigned char* VB = (const unsigned char*)(ws + WS_VB);
    LAS unsigned char* img = F.lds + RING_OFF + F.wave * 16384;
    LAS unsigned char* al = F.lds + LDSCTL_OFF + 4096 + F.wave * 128;
    constexpr int NCLS = T / 8;
    const int nk = wq < NCLS ? (NCLS - wq + NWQ - 1) / NWQ : 0;
    const int nit = 4 * nk;
    if (nit == 0) return;
    const int coff = 16 * r + 4 * kq;
    f32x4 gq[4];
#pragma unroll
    for (int q = 0; q < 4; ++q) gq[q] = *(const f32x4*)(a.in[I_FING] + 256 * ((j + q) & 3) + coff);
    unsigned e[8]; v4u R[16]; v2u xw; unsigned short av; v2u xq[3] = {(v2u){0u, 0u}, (v2u){0u, 0u}, (v2u){0u, 0u}};
#define PV_DECODE(it, tok_, sl_, s_, tb_) const int b_##tok_ = (it) >> 6, rem_##tok_ = (it) & 63, nb_##tok_ = (nk - 16 * b_##tok_) < 16 ? (nk - 16 * b_##tok_) : 16; \
        const int s_ = nb_##tok_ == 16 ? rem_##tok_ >> 4 : rem_##tok_ / nb_##tok_, tb_ = rem_##tok_ - s_ * nb_##tok_; \
        const int tok_ = 8 * (wq + (16 * b_##tok_ + tb_) * NWQ) + j, sl_ = (j + s_) & 3
#define PV_ISSUE(t, sl_) do { const unsigned char* VS_ = VB + (size_t)(sl_) * NEXP * 128; _Pragma("unroll") for (int i = 0; i < 16; ++i) R[i] = *(const GAS v4u*)(VS_ + (size_t)PE_ID(e, i) * 128 + 16 * seg); \
        xw = *(const GAS v2u*)(X2 + (size_t)(t) * D + 256 * (sl_) + coff); av = *(const GAS unsigned short*)(ACT + (size_t)(t) * 128 + 2 * lane); } while (0)
    { PV_DECODE(0, tk0, sl0, s0, tb0); pe_ids(e, EIDX, tk0, g); PV_ISSUE(tk0, sl0); }
    if (1 < nit) { PV_DECODE(1, tk1, sl1, s1, tb1); pe_ids(e, EIDX, tk1, g); }
    for (int it = 0; it < nit; ++it) {
        PV_DECODE(it, tok, sl, s, tb);
#pragma unroll
        for (int i = 0; i < 16; ++i) *(LAS v4u*)(img + (16 * g + i) * 128 + ((seg ^ (i & 7)) << 4)) = R[i];
        *(LAS unsigned short*)(al + 2 * lane) = av;
        const v2u xcur = xw;
        asm volatile("" ::: "memory");
        if (it + 1 < nit) { PV_DECODE(it + 1, tkn, sln, sn, tbn); PV_ISSUE(tkn, sln); }
        if (it + 2 < nit) { PV_DECODE(it + 2, tkm, slm, sm, tbm); pe_ids(e, EIDX, tkm, g); }
        __builtin_amdgcn_sched_barrier(0);
        const i32x4 blo = *(const LAS i32x4*)(al + 16 * kq), bhi = *(const LAS i32x4*)(al + 64 + 16 * kq);
        const i32x8 bfrag = __builtin_shufflevector(blo, bhi, 0, 1, 2, 3, 4, 5, 6, 7);
        pg8::f32x4 mine = (pg8::f32x4){0.f, 0.f, 0.f, 0.f};
        const int s0_ = 32 * kq + r, s1_ = s0_ + 16;
#define VTR(slot_, ct_) __builtin_amdgcn_ds_read_tr4_b64_v2i32((LAS i32x2*)(img + (slot_) * 128 + (((((ct_) >> 1) ^ ((slot_) & 7))) << 4) + 8 * ((ct_) & 1)))
        i32x2 tr[4];
        tr[0] = VTR(s0_, 0); tr[1] = VTR(s1_, 0);
        __builtin_amdgcn_sched_group_barrier(0x100, 4, 0);
#pragma unroll
        for (int ct = 0; ct < 16; ++ct) {
            const i32x2 t0 = tr[(2 * ct) & 3], t1 = tr[(2 * ct + 1) & 3];
            if (ct + 1 < 16) { tr[(2 * ct + 2) & 3] = VTR(s0_, ct + 1); tr[(2 * ct + 3) & 3] = VTR(s1_, ct + 1); }
            const i32x4 a4 = (i32x4){t0[0], t0[1], t1[0], t1[1]};
            const pg8::f32x4 z = __builtin_amdgcn_mfma_scale_f32_16x16x128_f8f6f4(__builtin_shufflevector(a4, a4, 0, 1, 2, 3, 4, 5, 6, 7), bfrag, (pg8::f32x4){0.f, 0.f, 0.f, 0.f}, 4, 0, 0, 0x7f7f7f7f, 0, 0x7f7f7f7f);
            __builtin_amdgcn_sched_group_barrier(0x100, 2, 0); __builtin_amdgcn_sched_group_barrier(0x8, 1, 0);
            if (r == ct) mine = z;
        }
#undef VTR
        const float sc = 1.0f / (V_SCALE * A_SCALE);
        const float o0 = bflo(xcur[0]) + mine[0] * sc, o1 = bfhi(xcur[0]) + mine[1] * sc, o2 = bflo(xcur[1]) + mine[2] * sc, o3 = bfhi(xcur[1]) + mine[3] * sc;
        const v2u ocur = (v2u){pk2(o0, o1), pk2(o2, o3)};
        if (s < 3) *(GAS v2u*)(X3 + (size_t)tok * D + 256 * sl + coff) = ocur;
        else {
            f32x4 xv[4]; float ssq = 0.f;
#pragma unroll
            for (int q = 0; q < 4; ++q) { const v2u w = q < 3 ? xq[q] : ocur; const unsigned w0 = w[0], w1 = w[1]; xv[q] = (f32x4){bflo(w0), bfhi(w0), bflo(w1), bfhi(w1)};
                ssq += (xv[q][0] * xv[q][0] + xv[q][1] * xv[q][1]) + (xv[q][2] * xv[q][2] + xv[q][3] * xv[q][3]); }
            const float rn = 1.0f / sqrtf(wave_sum(ssq) * (1.0f / D) + EPS);
            float* orow = a.out + (size_t)tok * D + coff;
#pragma unroll
            for (int q = 0; q < 4; ++q) __builtin_nontemporal_store(xv[q] * gq[q] * rn, (GAS f32x4*)(orow + 256 * ((j + q) & 3)));
        }
        if (it + 1 < nit) { PV_DECODE(it + 1, tkr, slr, sr, tbr);
            if (sr == 3) {
#pragma unroll
                for (int q = 0; q < 3; ++q) xq[q] = *(const GAS v2u*)(X3 + (size_t)tkr * D + 256 * ((j + q) & 3) + coff); } }
        asm volatile("" ::: "memory");
    }
#undef PV_ISSUE
#undef PV_DECODE
}
DI void final_phase(const Args& a, const Ctx& F) {
    const float* gf = a.in[I_FING]; const bf16* X3 = (const bf16*)(a.ws + WS_S3);
    const int lane = F.lane, gw = F.vcu * NWAVES + F.wave, NGW = F.G * NWAVES;
    const f32x4 ga0 = *(const f32x4*)(gf + 8 * lane), ga1 = *(const f32x4*)(gf + 8 * lane + 4), gb0 = *(const f32x4*)(gf + 512 + 8 * lane), gb1 = *(const f32x4*)(gf + 512 + 8 * lane + 4);
    for (int tok = gw; tok < T; tok += NGW) {
        const v4u xa = __builtin_nontemporal_load((const GAS v4u*)(X3 + (size_t)tok * D + 8 * lane)), xb = __builtin_nontemporal_load((const GAS v4u*)(X3 + (size_t)tok * D + 512 + 8 * lane));
        A4 a0, a1, b0, b1; unpack8(xa, a0, a1); unpack8(xb, b0, b1);
        float s = (a0[0] * a0[0] + a0[1] * a0[1]) + (a0[2] * a0[2] + a0[3] * a0[3]) + (a1[0] * a1[0] + a1[1] * a1[1]) + (a1[2] * a1[2] + a1[3] * a1[3])
                + (b0[0] * b0[0] + b0[1] * b0[1]) + (b0[2] * b0[2] + b0[3] * b0[3]) + (b1[0] * b1[0] + b1[1] * b1[1]) + (b1[2] * b1[2] + b1[3] * b1[3]);
        const float rn = 1.0f / sqrtf(wave_sum(s) * (1.0f / D) + EPS);
        float* orow = a.out + (size_t)tok * D;
        __builtin_nontemporal_store(a0 * ga0 * rn, (GAS f32x4*)(orow + 8 * lane)); __builtin_nontemporal_store(a1 * ga1 * rn, (GAS f32x4*)(orow + 8 * lane + 4));
        __builtin_nontemporal_store(b0 * gb0 * rn, (GAS f32x4*)(orow + 512 + 8 * lane)); __builtin_nontemporal_store(b1 * gb1 * rn, (GAS f32x4*)(orow + 512 + 8 * lane + 4));
    }
}

__global__ void __launch_bounds__(NWAVES * 64, 2) fwd(Args args) {
    extern __shared__ __attribute__((aligned(16))) unsigned char lds[];
    Ctx F;
    F.lds = (LAS unsigned char*)lds;
    F.tid = threadIdx.x; F.lane = F.tid & 63; F.wave = __builtin_amdgcn_readfirstlane(F.tid >> 6);
    F.G = gridDim.x; { const int bx = blockIdx.x; F.vcu = (F.G % 8 == 0) ? (bx % 8) * (F.G / 8) + bx / 8 : bx; }
    volatile LAS unsigned* MISC = (volatile LAS unsigned*)(F.lds + MISC_OFF);
    unsigned char* ws = args.ws;
    gu32* ctl = (gu32*)(ws + WS_CTL);
    for (int u = F.tid; u < (LDS_BYTES - LDSCTL_OFF) / 4; u += NWAVES * 64) ((LAS unsigned*)(F.lds + LDSCTL_OFF))[u] = 0u;
    __syncthreads();
    XcdBarrier bar; bar.bar = (unsigned*)(ctl + CW_BAR); bar.x = 0; bar.st = nullptr; bar.wv = F.wave;
    if (N_LAUNCHES == 1) { bar = xcd_barrier_post((unsigned*)(ctl + CW_BAR), MISC + 8); bar.wv = F.wave; }
#if XCC_LABELS
    if (N_LAUNCHES == 1 && F.tid == 0) { const unsigned x = xb_xcc_id() & 7u; MISC[16] = x; MISC[17] = __hip_atomic_fetch_add(ctl + CW_XRANK + 64 * x, 1u, RLX_AGENT); }
    __syncthreads();
#endif
#define GRID_BAR() do { if (N_LAUNCHES == 1) xcd_barrier(bar); } while (0)
    const int lo = args.ph_lo, hi = args.ph_hi;
#ifndef PH_MASK
#define PH_MASK 0x7fff
#endif
#ifndef PH_REP
#define PH_REP 0x000
#endif
#define REPS(k) (1 + ((PH_REP >> (k)) & 1))
#define IN(k) (((PH_MASK >> (k)) & 1) && lo <= (k) && (k) < hi)
#define BOTH(k) (IN(k) && IN((k) + 1))
    LAS unsigned char* ring = F.lds + RING_OFF;
    const int bid = (int)blockIdx.x;

    if (IN(0)) { for (int rep = 0; rep < REPS(0); ++rep) p0_prologue(args, fresh(F)); if (BOTH(0)) GRID_BAR(); }

    if (IN(1)) { {
        { pg8::Gemm g{(const bf16*)(ws + WS_S0), (const bf16*)(ws + WS_WIN), T, INC, D}; pg8::StaticOrder S; S.init(T, INC, F.G, bid);
          EpiIn E{(const float*)(ws + WS_RS0), args.in[I_CFB1], ws};
          pg8::gemm_phase<EpiIn, pg8::StaticOrder, PG8_ALIGN, PG8_SP2>(ring, g, S, E, F.wave); }
        kv_gemm(args, fresh(F)); }
        if (BOTH(1)) GRID_BAR();
    }

    if (IN(2)) { for (int rep = 0; rep < REPS(2); ++rep) conv_phase(args, fresh(F)); if (BOTH(2)) GRID_BAR(); }

    if (IN(3)) {
        pg8::Gemm g{(const bf16*)args.out, (const bf16*)(ws + WS_WSC), T, D, D}; pg8::StaticOrder S; S.init(T, D, F.G, bid);
        EpiMulGate E{(const bf16*)(ws + WS_S4), (bf16*)(ws + WS_S0)};
        pg8::gemm_phase<EpiMulGate, pg8::StaticOrder, PG8_ALIGN, PG8_SP2>(ring, g, S, E, F.wave);
    }
    if (IN(4)) {
        pg8::Gemm g{(const bf16*)((unsigned char*)args.out + 64 * MiB), (const bf16*)(ws + WS_WPW2), T, D, D}; pg8::StaticOrder S; S.init(T, D, F.G, bid);
        EpiMerge E{(const bf16*)(ws + WS_S5), (const bf16*)(ws + WS_S0), args.in[I_BPW2], (bf16*)(ws + WS_S1)};
        pg8::gemm_phase<EpiMerge, pg8::StaticOrder, PG8_ALIGN, PG8_SP2>(ring, g, S, E, F.wave);
        if (BOTH(4)) GRID_BAR();
    }
    if (IN(5)) {
        pg8::Gemm g{(const bf16*)(ws + WS_S1), (const bf16*)(ws + WS_WMIX), T, D, D}; pg8::StaticOrder S; S.init(T, D, F.G, bid);
        EpiResid<false> E{(const void*)args.in[I_X], (bf16*)(ws + WS_S2), (unsigned long long*)(ws + WS_SS1)};
        pg8::gemm_phase<EpiResid<false>, pg8::StaticOrder, PG8_ALIGN, PG8_SP2>(ring, g, S, E, F.wave);
        if (BOTH(5)) GRID_BAR();
    }
    if (IN(6)) {
        pg8::Gemm g{(const bf16*)(ws + WS_S2), (const bf16*)(ws + WS_WQ), T, D, D}; pg8::StaticOrder S; S.init(T, D, F.G, bid);
        EpiQFrag E{(const unsigned long long*)(ws + WS_SS1), (bf16*)(ws + WS_S3), 0.0625f * LOG2E};
        pg8::gemm_phase<EpiQFrag, pg8::StaticOrder, PG8_ALIGN, PG8_SP2>(ring, g, S, E, F.wave);
        if (BOTH(6) && N_LAUNCHES == 1) __builtin_amdgcn_fence(__ATOMIC_ACQUIRE, "agent");
    }
    if (IN(7)) { for (int rep = 0; rep < REPS(7); ++rep) attn_phase(args, fresh(F)); if (BOTH(7)) GRID_BAR(); }
    if (IN(8)) {
        pg8::Gemm g{(const bf16*)(ws + WS_S4), (const bf16*)(ws + WS_WXO), T, D, D}; pg8::StaticOrder S; S.init(T, D, F.G, bid);
        EpiResid<true> E{(const void*)(ws + WS_S2), (bf16*)(ws + WS_S5), (unsigned long long*)(ws + WS_SS2)};
        pg8::gemm_phase<EpiResid<true>, pg8::StaticOrder, PG8_ALIGN, PG8_SP2>(ring, g, S, E, F.wave);
        if (BOTH(8)) GRID_BAR();
    }
    if (IN(9)) {
        pg8::Gemm g{(const bf16*)(ws + WS_S5), (const bf16*)(ws + WS_WPQ), T, 2048, D}; pg8::StaticOrder S; S.init(T, 2048, F.G, bid);
        EpiPQFrag E{(const unsigned long long*)(ws + WS_SS2), (bf16*)args.out};
        pg8::gemm_phase<EpiPQFrag, pg8::StaticOrder, PG8_ALIGN, PG8_SP2>(ring, g, S, E, F.wave);
        if (BOTH(9)) GRID_BAR();
    }
    if (IN(10)) { for (int rep = 0; rep < REPS(10); ++rep) route_phase(args, fresh(F)); if (BOTH(10)) GRID_BAR(); }
    if (IN(11) || IN(13)) {
        F.xj = bid & 7; F.xrank = bid >> 3; F.xn = (F.G - F.xj + 7) >> 3;
#if XCC_LABELS
        if (N_LAUNCHES == 1) {
            bool even = true;
#pragma unroll
            for (int q = 0; q < 8; ++q) even = even && (__hip_atomic_load(ctl + CW_XRANK + 64 * q, RLX_AGENT) == (unsigned)(F.G >> 3));
            if (even && (F.G & 7) == 0) { F.xj = (int)MISC[16]; F.xrank = (int)MISC[17]; F.xn = F.G >> 3; }
        }
#endif
    }
    if (IN(11)) { for (int rep = 0; rep < REPS(11); ++rep) peer_u_phase(args, fresh(F)); if (BOTH(11)) GRID_BAR(); }
    if (IN(13)) { for (int rep = 0; rep < REPS(13); ++rep) peer_v_phase(args, fresh(F)); }
#undef IN
#undef BOTH
}

extern "C" void kernel_launch(void* const* d_in, const int* in_sizes, int n_in, void* d_out, int out_size, void* d_ws, size_t ws_size, hipStream_t stream) {
    static int grid = 0;
    if (grid == 0) {
        if (n_in != 25 || in_sizes[0] != T * D || out_size != T * D || ws_size < WS_END) { fprintf(stderr, "kernel_launch: unexpected shapes (n_in %d, in0 %d, out %d, ws %zu)\n", n_in, n_in > 0 ? in_sizes[0] : -1, out_size, ws_size); grid = -1; return; }
        int dev = 0, cus = 0, per_cu = 0;
        if (hipGetDevice(&dev) != hipSuccess || hipDeviceGetAttribute(&cus, hipDeviceAttributeMultiprocessorCount, dev) != hipSuccess) { grid = -1; return; }
        if (hipFuncSetAttribute((const void*)fwd, hipFuncAttributeMaxDynamicSharedMemorySize, LDS_BYTES) != hipSuccess) { fprintf(stderr, "kernel_launch: hipFuncSetAttribute failed\n"); grid = -1; return; }
        if (hipOccupancyMaxActiveBlocksPerMultiprocessor(&per_cu, (const void*)fwd, NWAVES * 64, LDS_BYTES) != hipSuccess || per_cu < 1) { fprintf(stderr, "kernel_launch: occupancy query says %d blocks/CU\n", per_cu); }
        (void)hipGetLastError();
        grid = cus;
    }
    if (grid < 0) return;
    (void)hipMemsetAsync((char*)d_ws + WS_CTL, 0, CTL_ZERO_BYTES, stream);
    Args a{};
    for (int i = 0; i < 25; ++i) a.in[i] = (const float*)d_in[i];
    a.out = (float*)d_out; a.ws = (unsigned char*)d_ws;
    if (N_LAUNCHES == 1) { a.ph_lo = 0; a.ph_hi = NPH; a.li = 0; hipLaunchKernelGGL(fwd, dim3(grid), dim3(NWAVES * 64), LDS_BYTES, stream, a); }
    else for (int li = 0; li < NPH; ++li) { a.ph_lo = li; a.ph_hi = li + 1; a.li = li; hipLaunchKernelGGL(fwd, dim3(grid), dim3(NWAVES * 64), LDS_BYTES, stream, a); }
}
```

```cpp
#include <hip/hip_runtime.h>
#include <cstdio>
#include <cstdint>
#include <utility>

#define NTL(p) (*(p))
#define NTS(v, p) (*(p) = (v))
#ifndef XCC_LABELS
#define XCC_LABELS 1
#endif
#ifndef MK_N_LAUNCHES
#define MK_N_LAUNCHES 1
#endif

#define DI __device__ __forceinline__
#define LAS __attribute__((address_space(3)))
__device__ __forceinline__ int tid_of_wave(int wave) { int l; asm volatile("v_mbcnt_lo_u32_b32 %0, -1, 0\n\tv_mbcnt_hi_u32_b32 %0, -1, %0" : "=v"(l)); return wave * 64 + l; }
#define GAS __attribute__((address_space(1)))

namespace pg8 {
#define PG8_LAS __attribute__((address_space(3)))
typedef unsigned short bf16_t;
typedef short bf16x8 __attribute__((ext_vector_type(8)));
typedef float f32x4 __attribute__((ext_vector_type(4)));
typedef unsigned u32x4 __attribute__((ext_vector_type(4)));
constexpr int BM = 256, BK = 64, HALF = 128, HTB = HALF * BK * 2, STAGE_BYTES = 8 * HTB, NXCD = 8, WGM = 8;

__host__ __device__ __forceinline__ int lds_byte(int r, int c) { const int st = (r >> 4) * 2 + (c >> 5), rr = r & 15, cc = c & 31, ob = rr * 64 + cc * 2; return st * 1024 + (ob ^ (((ob >> 9) & 1) << 5)); }
__host__ __device__ __forceinline__ void stage_rc(int b, int& R, int& C) { const int st = b / 1024, sb = b % 1024, swz = sb ^ (((sb >> 9) & 1) << 5); R = (st >> 1) * 16 + swz / 64; C = (st & 1) * 32 + (swz % 64) / 2; }
__host__ __device__ __forceinline__ int perm32(int rho) { const int n = rho >> 4, i = rho & 15; return 8 * (i >> 2) + 4 * n + (i & 3); }

struct Unit { int pm, pn; };
struct Gemm { const bf16_t* A; const bf16_t* Bt; int M, N, K; };

struct StaticOrder {
    int nM, nN, nwg, G, c;
    __host__ __device__ void init(int M, int N, int G_, int c_) { nM = M / BM; nN = N / BM; nwg = nM * nN; G = G_; c = c_; }
    __host__ __device__ bool next(int i, Unit& u) const {
        const long L = (long)i * G + c; if (L >= nwg) return false;
        int wgid = (int)L; { const int q = nwg / NXCD, r = nwg % NXCD, xcd = wgid % NXCD, off = wgid / NXCD; wgid = (xcd < r ? xcd * (q + 1) : r * (q + 1) + (xcd - r) * q) + off; }
        const int nig = WGM * nN, gid = wgid / nig, fm = gid * WGM, gsz = (nM - fm) < WGM ? (nM - fm) : WGM;
        u.pm = fm + ((wgid % nig) % gsz); u.pn = (wgid % nig) / gsz; return true;
    }
    __device__ __forceinline__ void a_ready(const Unit&) const {}
    __device__ __forceinline__ void done(const Unit&) const {}
};

__device__ __forceinline__ unsigned cvt_pk_bf16(float lo, float hi) { unsigned r; asm volatile("v_cvt_pk_bf16_f32 %0, %1, %2" : "=v"(r) : "v"(lo), "v"(hi)); return r; }

typedef int i32x4_t __attribute__((ext_vector_type(4)));
typedef int i32x8_t __attribute__((ext_vector_type(8)));
typedef long i64x2_t __attribute__((ext_vector_type(2)));
template <class Epi, class Sched, bool ALIGN_EPI = false, bool SP2 = false, bool FP8 = false>
__device__ __forceinline__ void gemm_phase(PG8_LAS unsigned char* lds, const Gemm g, const Sched& S, const Epi& E, int wave_) {
    int tid_ = tid_of_wave(wave_); asm volatile("" : "+v"(tid_));
    const int tid = tid_, wid = __builtin_amdgcn_readfirstlane(tid >> 6), lane = tid & 63, wr = wid >> 2, wc = wid & 3, fr = lane & 15, fq = lane >> 4;
    constexpr int EB = FP8 ? 1 : 2;
    const int K = g.K, nt = K * EB / (BK * 2);
    unsigned voffA[2], voffB[2];
#pragma unroll
    for (int i = 0; i < 2; ++i) { int R, C; stage_rc(tid * 16 + i * 8192, R, C); const int Rb = Epi::PERM ? ((R & ~31) + perm32(R & 31)) : R;
        voffA[i] = (unsigned)(R * K * EB + C * 2); voffB[i] = (unsigned)(Rb * K * EB + C * 2); }
    const size_t kstep = (size_t)(BK * 2);
    const size_t hstep = (size_t)HALF * K * EB;
    const size_t tstep = 2 * hstep;
    const unsigned ldsw = (unsigned)wid * 1024u;
    const unsigned ldsbase = (unsigned)__builtin_amdgcn_readfirstlane((int)((unsigned)(size_t)lds + ldsw));
    const int aoff = lds_byte(wr * 64 + fr, fq * 8), boff = lds_byte(wc * 32 + fr, fq * 8);
#define PG8_SA(b, h) (((b) * 2 + (h)) * HTB)
#define PG8_SB(b, h) ((4 + (b) * 2 + (h)) * HTB)
#define PG8_STAGE(bufoff, gbase, voff) do { _Pragma("unroll") for (int _i = 0; _i < 2; ++_i) { \
        const unsigned m0v_ = ldsbase + (unsigned)((bufoff) + _i * 8192); const char* gb_ = (const char*)(gbase); \
        asm volatile("s_mov_b32 m0, %2\n\ts_nop 0\n\tglobal_load_lds_dwordx4 %0, %1" :: "v"((voff)[_i]), "s"(gb_), "s"(m0v_) : "memory", "m0"); } } while (0)
#define PG8_LD8(base_) __builtin_shufflevector(__builtin_bit_cast(i32x4_t, *(const PG8_LAS bf16x8*)(base_)), __builtin_bit_cast(i32x4_t, *(const PG8_LAS bf16x8*)((base_) + 1024)), 0, 1, 2, 3, 4, 5, 6, 7)
#define PG8_LDA(dst, b, h) do { _Pragma("unroll") for (int m = 0; m < 4; ++m) _Pragma("unroll") for (int k = 0; k < 2; ++k) dst[m][k] = *(const PG8_LAS bf16x8*)(lds + PG8_SA(b, h) + aoff + m * 2048 + k * 1024); } while (0)
#define PG8_LDB(dst, b, h) do { _Pragma("unroll") for (int n = 0; n < 2; ++n) _Pragma("unroll") for (int k = 0; k < 2; ++k) dst[n][k] = *(const PG8_LAS bf16x8*)(lds + PG8_SB(b, h) + boff + n * 2048 + k * 1024); } while (0)
#define PG8_MMA(ai, bj, At, Bt) do { __builtin_amdgcn_s_setprio(1); _Pragma("unroll") for (int m = 0; m < 4; ++m) _Pragma("unroll") for (int n = 0; n < 2; ++n) { \
        if constexpr (FP8) { const i32x4_t b0_ = __builtin_bit_cast(i32x4_t, Bt[n][0]), b1_ = __builtin_bit_cast(i32x4_t, Bt[n][1]), a0_ = __builtin_bit_cast(i32x4_t, At[m][0]), a1_ = __builtin_bit_cast(i32x4_t, At[m][1]); \
            acc[ai][bj][m][n] = __builtin_amdgcn_mfma_scale_f32_16x16x128_f8f6f4(__builtin_shufflevector(b0_, b1_, 0, 1, 2, 3, 4, 5, 6, 7), __builtin_shufflevector(a0_, a1_, 0, 1, 2, 3, 4, 5, 6, 7), acc[ai][bj][m][n], 0, 0, 0, 0, 0, 0); } \
        else { _Pragma("unroll") for (int k = 0; k < 2; ++k) acc[ai][bj][m][n] = __builtin_amdgcn_mfma_f32_16x16x32_bf16(Bt[n][k], At[m][k], acc[ai][bj][m][n], 0, 0, 0); } } \
        __builtin_amdgcn_s_setprio(0); } while (0)
#define PG8_WAIT_V(n) asm volatile("s_waitcnt vmcnt(" #n ")" ::: "memory")
#define PG8_WAIT_L(n) asm volatile("s_waitcnt lgkmcnt(" #n ")" ::: "memory")
#define PG8_BAR __builtin_amdgcn_s_barrier()
#define PG8_SCHED __builtin_amdgcn_sched_barrier(0)
    Unit cur, nxt; int ui = 0;
    if (!S.next(0, cur)) return;
    f32x4 acc[2][2][4][2];
#pragma unroll
    for (int a = 0; a < 2; ++a)
#pragma unroll
        for (int b = 0; b < 2; ++b)
#pragma unroll
            for (int m = 0; m < 4; ++m)
#pragma unroll
                for (int n = 0; n < 2; ++n) acc[a][b][m][n] = (f32x4){0.f, 0.f, 0.f, 0.f};
    bf16x8 At[4][2], B0[2][2], B1[2][2];
    const char* cA = (const char*)g.A + (size_t)cur.pm * tstep; const char* cB = (const char*)g.Bt + (size_t)cur.pn * tstep;
    S.a_ready(cur);
    if constexpr (SP2) {
        PG8_STAGE(PG8_SB(0, 0), cB, voffB); PG8_STAGE(PG8_SB(0, 1), cB + hstep, voffB); PG8_STAGE(PG8_SA(0, 0), cA, voffA); PG8_STAGE(PG8_SA(0, 1), cA + hstep, voffA);
        if (wr == 1) PG8_BAR;
        PG8_WAIT_V(2); PG8_BAR;
        PG8_STAGE(PG8_SB(1, 0), cB + kstep, voffB); PG8_STAGE(PG8_SA(1, 0), cA + kstep, voffA); PG8_STAGE(PG8_SB(1, 1), cB + hstep + kstep, voffB);
        PG8_WAIT_V(6); PG8_BAR;
    } else {
        PG8_STAGE(PG8_SB(0, 0), cB, voffB); PG8_STAGE(PG8_SA(0, 0), cA, voffA); PG8_STAGE(PG8_SB(0, 1), cB + hstep, voffB); PG8_STAGE(PG8_SA(0, 1), cA + hstep, voffA);
        if (wr == 1) PG8_BAR;
        PG8_WAIT_V(4); PG8_BAR;
        PG8_STAGE(PG8_SB(1, 0), cB + kstep, voffB); PG8_STAGE(PG8_SA(1, 0), cA + kstep, voffA); PG8_STAGE(PG8_SB(1, 1), cB + hstep + kstep, voffB);
        PG8_WAIT_V(6); PG8_BAR;
    }
    for (;;) {
        const bool has_next = S.next(ui + 1, nxt);
        const char* nA = has_next ? (const char*)g.A + (size_t)nxt.pm * tstep : cA; const char* nB = has_next ? (const char*)g.Bt + (size_t)nxt.pn * tstep : cB;
#pragma nounroll
        for (int t = 0; t < nt; t += 2) {
            const bool last = (t == nt - 2);
            const char* a1 = cA + (size_t)(t + 1) * kstep;
            const char* a2 = last ? nA : cA + (size_t)(t + 2) * kstep; const char* b2 = last ? nB : cB + (size_t)(t + 2) * kstep;
            const char* a3 = a2 + kstep; const char* b3 = b2 + kstep;
            if (last && has_next) S.a_ready(nxt);
            if constexpr (SP2) {
            PG8_LDB(B0, 0, 0); PG8_LDB(B1, 0, 1); PG8_SCHED; PG8_LDA(At, 0, 0); PG8_STAGE(PG8_SA(1, 1), a1 + hstep, voffA);
            PG8_WAIT_V(8); PG8_WAIT_L(0); PG8_BAR; PG8_MMA(0, 0, At, B0); PG8_MMA(0, 1, At, B1); PG8_BAR; PG8_SCHED;
            PG8_LDA(At, 0, 1); PG8_STAGE(PG8_SB(0, 0), b2, voffB); PG8_STAGE(PG8_SB(0, 1), b2 + hstep, voffB); PG8_STAGE(PG8_SA(0, 0), a2, voffA);
            PG8_WAIT_V(8); PG8_WAIT_L(0); PG8_BAR; PG8_MMA(1, 0, At, B0); PG8_MMA(1, 1, At, B1); PG8_BAR; PG8_SCHED;
            PG8_LDB(B0, 1, 0); PG8_LDB(B1, 1, 1); PG8_SCHED; PG8_LDA(At, 1, 0); PG8_STAGE(PG8_SA(0, 1), a2 + hstep, voffA);
            PG8_WAIT_V(8); PG8_WAIT_L(0); PG8_BAR; PG8_MMA(0, 0, At, B0); PG8_MMA(0, 1, At, B1); PG8_BAR; PG8_SCHED;
            PG8_LDA(At, 1, 1); PG8_STAGE(PG8_SB(1, 0), b3, voffB); PG8_STAGE(PG8_SB(1, 1), b3 + hstep, voffB); PG8_STAGE(PG8_SA(1, 0), a3, voffA);
            PG8_WAIT_V(8); PG8_WAIT_L(0); PG8_BAR; PG8_MMA(1, 0, At, B0); PG8_MMA(1, 1, At, B1); PG8_BAR; PG8_SCHED;
            } else {
            PG8_LDB(B0, 0, 0); PG8_SCHED; PG8_LDA(At, 0, 0); PG8_STAGE(PG8_SA(1, 1), a1 + hstep, voffA);
            PG8_WAIT_L(8); PG8_BAR; PG8_WAIT_L(0); PG8_MMA(0, 0, At, B0); PG8_BAR; PG8_SCHED;
            PG8_LDB(B1, 0, 1); PG8_STAGE(PG8_SB(0, 0), b2, voffB);
            PG8_BAR; PG8_WAIT_L(0); PG8_MMA(0, 1, At, B1); PG8_BAR;
            PG8_LDA(At, 0, 1); PG8_STAGE(PG8_SA(0, 0), a2, voffA);
            PG8_BAR; PG8_WAIT_L(0); PG8_MMA(1, 0, At, B0); PG8_BAR; PG8_SCHED;
            PG8_STAGE(PG8_SB(0, 1), b2 + hstep, voffB);
            PG8_WAIT_V(6); PG8_BAR; PG8_MMA(1, 1, At, B1); PG8_BAR;
            PG8_LDB(B0, 1, 0); PG8_SCHED; PG8_LDA(At, 1, 0); PG8_STAGE(PG8_SA(0, 1), a2 + hstep, voffA);
            PG8_WAIT_L(8); PG8_BAR; PG8_WAIT_L(0); PG8_MMA(0, 0, At, B0); PG8_BAR; PG8_SCHED;
            PG8_LDB(B1, 1, 1); PG8_STAGE(PG8_SB(1, 0), b3, voffB);
            PG8_BAR; PG8_WAIT_L(0); PG8_MMA(0, 1, At, B1); PG8_BAR;
            PG8_LDA(At, 1, 1); PG8_STAGE(PG8_SA(1, 0), a3, voffA);
            PG8_BAR; PG8_WAIT_L(0); PG8_MMA(1, 0, At, B0); PG8_BAR; PG8_SCHED;
            PG8_STAGE(PG8_SB(1, 1), b3 + hstep, voffB);
            PG8_WAIT_V(6); PG8_BAR; PG8_MMA(1, 1, At, B1); PG8_BAR;
            }
        }
        if constexpr (ALIGN_EPI) { if (wr == 0) PG8_BAR; }
        { const int l2_ = tid_of_wave(wave_) & 63; E(acc, cur, wr, wc, l2_ & 15, l2_ >> 4); }
        S.done(cur);
        if constexpr (FP8) {
            int t2_ = tid_of_wave(wave_); asm volatile("" : "+v"(t2_));
#pragma unroll
            for (int i = 0; i < 2; ++i) { int R, C; stage_rc(t2_ * 16 + i * 8192, R, C); const int Rb = Epi::PERM ? ((R & ~31) + perm32(R & 31)) : R;
                voffA[i] = (unsigned)(R * K * EB + C * 2); voffB[i] = (unsigned)(Rb * K * EB + C * 2); }
        }
        if (!has_next) break;
#pragma unroll
        for (int a = 0; a < 2; ++a)
#pragma unroll
            for (int b = 0; b < 2; ++b)
#pragma unroll
                for (int m = 0; m < 4; ++m)
#pragma unroll
                    for (int n = 0; n < 2; ++n) acc[a][b][m][n] = (f32x4){0.f, 0.f, 0.f, 0.f};
        cur = nxt; cA = nA; cB = nB; ++ui;
        if constexpr (ALIGN_EPI) { if (wr == 1) PG8_BAR; }
    }
    PG8_WAIT_V(0);
    if constexpr (!ALIGN_EPI) { if (wr == 0) PG8_BAR; }
    PG8_BAR;
#undef PG8_SA
#undef PG8_SB
#undef PG8_STAGE
#undef PG8_LDA
#undef PG8_LDB
#undef PG8_MMA
#undef PG8_WAIT_V
#undef PG8_WAIT_L
#undef PG8_BAR
#undef PG8_SCHED
}
}

#ifndef PG8_SP2
#define PG8_SP2 true
#endif
#ifndef PG8_ALIGN
#define PG8_ALIGN true
#endif

constexpr int NWAVES = 8;
constexpr int N_LAUNCHES = MK_N_LAUNCHES;
constexpr int NPH = 15;
constexpr int D = 1024, BATCH = 8, SEQ = 4096, T = BATCH * SEQ, NMEM = 256, MROWS = BATCH * NMEM;
constexpr int INC = 7168, NEXP = 16384;
constexpr float EPS = 1e-6f;
constexpr float LOG2E = 1.4426950408889634f;

constexpr size_t MiB = 1u << 20;
constexpr size_t WS_CTL = 0, CTL_ZERO_BYTES = 1 * MiB;
constexpr size_t WS_SS1 = 256 * 1024, WS_SS2 = 512 * 1024;
constexpr float SS_FIX = 16777216.0f, SS_UNFIX = 1.0f / 16777216.0f;
DI float ss_get(const unsigned long long* p, int r) { return (float)p[r] * SS_UNFIX; }
constexpr size_t WS_WIN = 1 * MiB, WS_WSC = 15 * MiB, WS_WPW2 = 17 * MiB, WS_WMIX = 19 * MiB, WS_WQ = 21 * MiB, WS_WXO = 23 * MiB, WS_WKV = 25 * MiB, WS_WPQ = 29 * MiB;
constexpr size_t WS_SKB = 33 * MiB, WS_RS0 = 33 * MiB + 128 * 1024, WS_RSM = 33 * MiB + 256 * 1024;
constexpr size_t WS_WG8 = 50 * MiB, WS_X8 = 66 * MiB;
constexpr float WG_SCALE = 64.0f;
constexpr size_t WS_KB = 34 * MiB, WS_VT = 38 * MiB, WS_UB = 42 * MiB, WS_VB = 58 * MiB;
constexpr float U_SCALE = 64.0f, V_SCALE = 6.0f, A_SCALE = 16.0f;
constexpr size_t WS_S0 = 106 * MiB, WS_S1 = 170 * MiB, WS_S2 = 234 * MiB, WS_S3 = 298 * MiB, WS_S4 = 362 * MiB, WS_S5 = 426 * MiB, WS_END = 490 * MiB;
constexpr int CW_TMO = 0, CW_CODE = 1, CW_BAR = 4096, CW_XRANK = 8192;

constexpr int RING_OFF = 0, RING_BYTES = 131072;
constexpr int LDSCTL_OFF = RING_BYTES, MISC_OFF = LDSCTL_OFF + 320;
constexpr int LDS_BYTES = 163840, ZACC_OFF = LDSCTL_OFF + 3072;

typedef unsigned short bf16;
typedef unsigned v4u __attribute__((ext_vector_type(4)));
typedef unsigned v2u __attribute__((ext_vector_type(2)));
typedef float f32x4 __attribute__((ext_vector_type(4)));
typedef float f32x2 __attribute__((ext_vector_type(2)));
typedef float f32x16 __attribute__((ext_vector_type(16)));
typedef int i32x2 __attribute__((ext_vector_type(2)));
typedef int i32x4 __attribute__((ext_vector_type(4)));
typedef int i32x8 __attribute__((ext_vector_type(8)));
typedef short bf16x8 __attribute__((ext_vector_type(8)));
typedef __bf16 bf2_t __attribute__((ext_vector_type(2)));
typedef GAS unsigned gu32;
#define RLX_AGENT __ATOMIC_RELAXED, __HIP_MEMORY_SCOPE_AGENT
#define LDS_WAIT() asm volatile("s_waitcnt lgkmcnt(0)" ::: "memory")
#define VM_WAIT() asm volatile("s_waitcnt vmcnt(0)" ::: "memory")
DI unsigned f2bf(float f) { unsigned u = __builtin_bit_cast(unsigned, f); return (u + 0x7fffu + ((u >> 16) & 1u)) >> 16; }
DI unsigned pk2(float lo, float hi) { return pg8::cvt_pk_bf16(lo, hi); }
DI float bflo(unsigned w) { return __builtin_bit_cast(float, w << 16); }
DI float bfhi(unsigned w) { return __builtin_bit_cast(float, w & 0xffff0000u); }
DI float sigmoidf_(float x) { return __builtin_amdgcn_rcpf(1.0f + __builtin_amdgcn_exp2f(-x * LOG2E)); }
DI float fmax_(float a, float b) { float r; asm("v_max_f32_e32 %0, %1, %2" : "=v"(r) : "v"(a), "v"(b)); return r; }
DI float fmin_(float a, float b) { float r; asm("v_min_f32_e32 %0, %1, %2" : "=v"(r) : "v"(a), "v"(b)); return r; }

#define XB_TMO      128
#define XB_XCNT(j)  (256  + 64 * (j))
#define XB_XSUB(j)  (1280 + 64 * (j))
#define XB_XGEN(j)  (2304 + 64 * (j))
#define XB_TOP      3328
#define XB_TOPGEN   3392
#define XCD_BAR_WORDS 3456
#define XB_SPIN_CAP (1u << 18)
DI unsigned xb_ld(unsigned* p)              { return __hip_atomic_load(p, __ATOMIC_RELAXED, __HIP_MEMORY_SCOPE_AGENT); }
DI unsigned xb_add(unsigned* p, unsigned v) { return __hip_atomic_fetch_add(p, v, __ATOMIC_RELAXED, __HIP_MEMORY_SCOPE_AGENT); }
DI unsigned xb_xcc_id() { return (unsigned)__builtin_amdgcn_s_getreg((3 << 11) | 20) & 0xFu; }
#define XB_SPIN(cond, bar) do { unsigned _sp = 0; while (cond) { __builtin_amdgcn_s_sleep(1); \
    if ((++_sp & 255u) == 0u) { if (xb_ld(&(bar)[XB_TMO])) break; if (_sp > XB_SPIN_CAP) { atomicAdd(&(bar)[XB_TMO], 1u); break; } } } } while (0)
struct XcdBarrier { unsigned* bar; unsigned x; volatile LAS unsigned* st; int wv; };
DI XcdBarrier xcd_barrier_post(unsigned* bar, volatile LAS unsigned* st) {
    XcdBarrier b; b.bar = bar; b.x = xb_xcc_id(); b.st = st;
    if (threadIdx.x == 0) (void)xb_add(&bar[XB_XCNT(b.x)], 1u);
    return b;
}
DI void xcd_barrier_complete(unsigned* bar, unsigned x, unsigned& nloc, unsigned& nx) {
    const unsigned G = gridDim.x * gridDim.y * gridDim.z;
    unsigned sum, cnt, mine, sp = 0u;
    for (;;) {
        sum = 0u; cnt = 0u; mine = 0u;
#pragma unroll
        for (unsigned j = 0; j < 16; ++j) { const unsigned c = xb_ld(&bar[XB_XCNT(j)]); sum += c; cnt += (c > 0u) ? 1u : 0u; mine = (j == x) ? c : mine; }
        if (sum == G) break;
        __builtin_amdgcn_s_sleep(1);
        if ((++sp & 255u) == 0u) { if (xb_ld(&bar[XB_TMO])) break; if (sp > XB_SPIN_CAP) { atomicAdd(&bar[XB_TMO], 1u); break; } }
    }
    nloc = mine > 0u ? mine : 1u; nx = cnt > 0u ? cnt : 1u;
}
DI void xcd_barrier(const XcdBarrier& b) {
    asm volatile("s_waitcnt vmcnt(0)" ::: "memory");
    __syncthreads();
    if (tid_of_wave(b.wv) == 0) {
        unsigned* bar = b.bar;
        __builtin_amdgcn_s_waitcnt(0);
        unsigned nloc = b.st[0], nx = b.st[1];
        if (nloc == 0u) { xcd_barrier_complete(bar, b.x, nloc, nx); b.st[0] = nloc; b.st[1] = nx; }
        const unsigned old = xb_add(&bar[XB_XSUB(b.x)], 1u);
        const unsigned gen = old / nloc;
        if (old + 1u == (gen + 1u) * nloc) {
            __builtin_amdgcn_fence(__ATOMIC_RELEASE, "agent");
            asm volatile("s_waitcnt vmcnt(0)" ::: "memory");
            const unsigned og = xb_add(&bar[XB_TOP], 1u);
            const unsigned tg = og / nx;
            if (og + 1u == (tg + 1u) * nx) xb_add(&bar[XB_TOPGEN], 1u);
            else XB_SPIN(xb_ld(&bar[XB_TOPGEN]) == tg, bar);
            __builtin_amdgcn_fence(__ATOMIC_ACQUIRE, "agent");
            xb_add(&bar[XB_XGEN(b.x)], 1u);
            asm volatile("s_waitcnt vmcnt(0)" ::: "memory");
        } else {
            XB_SPIN(xb_ld(&bar[XB_XGEN(b.x)]) == gen, bar);
            __builtin_amdgcn_fence(__ATOMIC_ACQUIRE, "agent");
            asm volatile("s_waitcnt vmcnt(0)" ::: "memory");
        }
    }
    __syncthreads();
}

struct Args { const float* in[25]; float* out; unsigned char* ws; int ph_lo, ph_hi, li, pad; };
enum { I_X = 0, I_MEM, I_NMIXG, I_WIN, I_CFB1, I_SCCW, I_SCWO, I_CFCW, I_CFCB, I_LNG, I_LNB, I_PW2, I_BPW2, I_WMIX, I_NXAG, I_NMEMG, I_WQ, I_WKV, I_WXO, I_NPEERG, I_WPQ, I_SUBK, I_PU, I_PV, I_FING };

struct Ctx { LAS unsigned char* lds; int tid, lane, wave, vcu, G; int xj, xrank, xn; };

DI Ctx fresh(const Ctx& F) { Ctx G = F; int t = tid_of_wave(F.wave); asm volatile("" : "+v"(t)); G.tid = t; G.lane = t & 63; return G; }
DI float wave_sum(float v) {
#pragma unroll
    for (int o = 1; o < 64; o <<= 1) v += __shfl_xor(v, o);
    return v;
}

template <int N, int LOGN> DI float treduce(float (&v)[N], int lane) {
#pragma unroll
    for (int s = 0; s < LOGN; ++s) {
        const int c = N >> (s + 1), mask = 32 >> s;
        const bool up = (lane & mask) != 0;
#pragma unroll
        for (int i = 0; i < c; ++i) { float lo = v[i], hi = v[i + c]; asm volatile("" : "+v"(lo), "+v"(hi));
            const float keep = up ? hi : lo; const float send = up ? lo : hi; v[i] = keep + __shfl_xor(send, mask); }
    }
    float r = v[0];
#pragma unroll
    for (int s = LOGN; s < 6; ++s) r += __shfl_xor(r, 32 >> s);
    return r;
}

DI void p0_transpose_item(const float* W, int K, int N, bf16* WT, const float* g, int k0, int c0, int n0d, LAS float* scr, int lane) {
#pragma unroll 8
    for (int i = 0; i < 32; ++i) { const int kk = 2 * i + (lane >> 5); const float s = g ? g[k0 + kk] : 1.0f; scr[kk * 33 + (lane & 31)] = __builtin_nontemporal_load(W + (size_t)(k0 + kk) * N + c0 + (lane & 31)) * s; }
    LDS_WAIT(); asm volatile("" ::: "memory");
    const int c = lane & 7;
#pragma unroll
    for (int j = 0; j < 4; ++j) { const int n = (lane >> 3) + 8 * j; const LAS float* s = scr + (8 * c) * 33 + n;
        v4u o; o.x = pk2(s[0 * 33], s[1 * 33]); o.y = pk2(s[2 * 33], s[3 * 33]); o.z = pk2(s[4 * 33], s[5 * 33]); o.w = pk2(s[6 * 33], s[7 * 33]);
        *(GAS v4u*)(WT + (size_t)(n0d + n) * K + k0 + 8 * c) = o; }
    LDS_WAIT(); asm volatile("" ::: "memory");
}
DI int win_src_col(int nd) {
    if (nd < 1024) return nd;
    if (nd < 3072) { const int q = (nd - 1024) >> 8, j = (nd - 1024) & 255; return 1024 + (j >> 7) * 1024 + 128 * q + (j & 127); }
    if (nd < 5120) { const int q = (nd - 3072) >> 8, j = (nd - 3072) & 255; return 3072 + (j >> 7) * 1024 + 128 * q + (j & 127); }
    return nd;
}
template <int NR, bool PRESCALE = false> DI void rows_to_bf16_rs(const float* x0, bf16* o0, float* rs, int lane, unsigned char* o8 = nullptr) {
    f32x4 v[NR][4];
#pragma unroll
    for (int q = 0; q < NR; ++q) { const GAS f32x4* xr = (const GAS f32x4*)(x0 + (size_t)q * D) + lane;
#pragma unroll
        for (int j = 0; j < 4; ++j) v[q][j] = __builtin_nontemporal_load(xr + 64 * j); }
#pragma unroll
    for (int q = 0; q < NR; ++q) {
        float s = 0.f;
#pragma unroll
        for (int j = 0; j < 4; ++j) s += (v[q][j].x * v[q][j].x + v[q][j].y * v[q][j].y) + (v[q][j].z * v[q][j].z + v[q][j].w * v[q][j].w);
        s = wave_sum(s);
        const float rsv = 1.0f / sqrtf(s * (1.0f / D) + EPS), ps = PRESCALE ? rsv : 1.0f;
        GAS v2u* ob = (GAS v2u*)(o0 + (size_t)q * D) + lane;
#pragma unroll
        for (int j = 0; j < 4; ++j) { v2u w; w.x = pk2(v[q][j].x * ps, v[q][j].y * ps); w.y = pk2(v[q][j].z * ps, v[q][j].w * ps); ob[64 * j] = w; }
        if (o8) {
#pragma unroll
            for (int j = 0; j < 4; ++j) { int w = 0; w = __builtin_amdgcn_cvt_pk_fp8_f32(v[q][j].x * ps, v[q][j].y * ps, w, false); w = __builtin_amdgcn_cvt_pk_fp8_f32(v[q][j].z * ps, v[q][j].w * ps, w, true);
                *(GAS unsigned*)(o8 + (size_t)q * D + 4 * (lane + 64 * j)) = (unsigned)w; } }
        if (lane == 0) rs[q] = rsv;
    }
}

DI void p0_prologue(const Args& a, const Ctx& F) {
    unsigned char* ws = a.ws;
    LAS float* scr = (LAS float*)(F.lds + RING_OFF + F.wave * 16384);
    const int gw = F.vcu * NWAVES + F.wave, NGW = F.G * NWAVES;
    {
        LAS float* tile = (LAS float*)(F.lds + RING_OFF);
        constexpr int NB_IN = INC / 256, NI_IN = 16 * NB_IN, NI_SQ = 16 * 4, NI_2K = 16 * 8, NITEMS = NI_IN + 5 * NI_SQ + 2 * NI_2K;
        for (int it = F.vcu; it < NITEMS; it += F.G) {
            const float* W; const float* g = nullptr; bf16* WT; int N, kb, nb; bool perm = false, isq = false, isxo = false, ispw = false, iskv = false;
            int rr = it;
            if (rr < NI_IN) { W = a.in[I_WIN]; g = a.in[I_NMIXG]; WT = (bf16*)(ws + WS_WIN); N = INC; kb = rr / NB_IN; nb = rr % NB_IN; perm = true; }
            else { rr -= NI_IN;
                if (rr < 5 * NI_SQ) { const int mi = rr / NI_SQ, q = rr % NI_SQ; kb = q / 4; nb = q % 4; N = D;
                    W = mi == 0 ? a.in[I_SCWO] : mi == 1 ? a.in[I_PW2] : mi == 2 ? a.in[I_WMIX] : mi == 3 ? a.in[I_WQ] : a.in[I_WXO];
                    WT = (bf16*)(ws + (mi == 0 ? WS_WSC : mi == 1 ? WS_WPW2 : mi == 2 ? WS_WMIX : mi == 3 ? WS_WQ : WS_WXO)); g = mi == 3 ? a.in[I_NXAG] : nullptr; isq = mi == 3; isxo = mi == 4; ispw = mi == 1; }
                else { rr -= 5 * NI_SQ; const int mi = rr / NI_2K, q = rr % NI_2K; kb = q / 8; nb = q % 8; N = 2048;
                    W = mi == 0 ? a.in[I_WKV] : a.in[I_WPQ]; WT = (bf16*)(ws + (mi == 0 ? WS_WKV : WS_WPQ)); g = mi == 0 ? a.in[I_NMEMG] : a.in[I_NPEERG]; iskv = mi == 0; } }
            const int k0 = 64 * kb, n0 = 256 * nb;
            const int c_lo = perm ? win_src_col(n0) : n0, c_hi = perm ? win_src_col(n0 + 128) : n0 + 128;
            const int csrc = ((F.lane >> 5) ? c_hi : c_lo) + 4 * (F.lane & 31);
#pragma unroll
            for (int q = 0; q < 8; ++q) { const int kl = 8 * F.wave + q; const float s = g ? g[k0 + kl] : 1.0f;
                const f32x4 v = __builtin_nontemporal_load((const GAS f32x4*)(W + (size_t)(k0 + kl) * N + csrc));
                LAS float* tp = tile + kl * 257 + 4 * F.lane; tp[0] = v.x * s; tp[1] = v.y * s; tp[2] = v.z * s; tp[3] = v.w * s; }
            __syncthreads();
            const int c = F.tid & 7;
#pragma unroll
            for (int q = 0; q < 4; ++q) { const int nl = (F.tid >> 3) + 64 * q; const LAS float* tp = tile + (8 * c) * 257 + nl;
                if ((perm && n0 >= 3072) || isq || isxo || ispw || iskv) { const int f8row0 = isq ? 4096 + n0 : isxo ? 5120 + n0 : ispw ? 6144 + n0 : iskv ? n0 - (int)((WS_WG8 - WS_WQ) / D) : n0 - 3072;
                    int w0 = 0, w1 = 0;
                    w0 = __builtin_amdgcn_cvt_pk_fp8_f32(tp[0] * WG_SCALE, tp[257] * WG_SCALE, w0, false); w0 = __builtin_amdgcn_cvt_pk_fp8_f32(tp[2 * 257] * WG_SCALE, tp[3 * 257] * WG_SCALE, w0, true);
                    w1 = __builtin_amdgcn_cvt_pk_fp8_f32(tp[4 * 257] * WG_SCALE, tp[5 * 257] * WG_SCALE, w1, false); w1 = __builtin_amdgcn_cvt_pk_fp8_f32(tp[6 * 257] * WG_SCALE, tp[7 * 257] * WG_SCALE, w1, true);
                    *(GAS v2u*)(ws + WS_WG8 + (long)(f8row0 + nl) * D + k0 + 8 * c) = (v2u){(unsigned)w0, (unsigned)w1};
                } else {
                v4u o; o.x = pk2(tp[0], tp[257]); o.y = pk2(tp[2 * 257], tp[3 * 257]); o.z = pk2(tp[4 * 257], tp[5 * 257]); o.w = pk2(tp[6 * 257], tp[7 * 257]);
                *(GAS v4u*)(WT + (size_t)(n0 + nl) * D + k0 + 8 * c) = o; } }
            __syncthreads();
        }
    }
    {
        const GAS f32x4* pg = (const GAS f32x4*)a.in[I_NPEERG];
        f32x4 g4[4];
#pragma unroll
        for (int q = 0; q < 4; ++q) g4[q] = pg[F.lane + 64 * q];
        unsigned char* ub = ws + WS_UB; unsigned char* vb = ws + WS_VB;
#pragma unroll 2
        for (int e = gw; e < NEXP; e += NGW) {
            const GAS f32x4* pu = (const GAS f32x4*)(a.in[I_PU] + (size_t)e * D) + F.lane; const GAS f32x4* pv = (const GAS f32x4*)(a.in[I_PV] + (size_t)e * D) + F.lane;
            f32x4 u[4], v[4];
#pragma unroll
            for (int q = 0; q < 4; ++q) { u[q] = __builtin_nontemporal_load(pu + 64 * q); v[q] = __builtin_nontemporal_load(pv + 64 * q); }
#pragma unroll
            for (int q = 0; q < 4; ++q) {
                const f32x4 uu = u[q] * g4[q] * U_SCALE, vv = v[q] * V_SCALE; unsigned uw = 0u, vw = 0u;
                uw = __builtin_amdgcn_cvt_scalef32_pk_fp4_f32(uw, uu.x, uu.y, 1.0f, 0); uw = __builtin_amdgcn_cvt_scalef32_pk_fp4_f32(uw, uu.z, uu.w, 1.0f, 1);
                vw = __builtin_amdgcn_cvt_scalef32_pk_fp4_f32(vw, vv.x, vv.y, 1.0f, 0); vw = __builtin_amdgcn_cvt_scalef32_pk_fp4_f32(vw, vv.z, vv.w, 1.0f, 1);
                *(GAS unsigned short*)(ub + ((size_t)q * NEXP + e) * 128 + 2 * F.lane) = (unsigned short)uw;
                *(GAS unsigned short*)(vb + ((size_t)q * NEXP + e) * 128 + 2 * F.lane) = (unsigned short)vw; }
        }
        const int gt = F.vcu * (NWAVES * 64) + F.tid, NGT = F.G * NWAVES * 64;
        const GAS f32x4* sk = (const GAS f32x4*)a.in[I_SUBK]; GAS v4u* skb = (GAS v4u*)(ws + WS_SKB);
        for (int i = gt; i < 2 * 128 * 128 / 8; i += NGT) {
            const f32x4 v0 = sk[2 * i], v1 = sk[2 * i + 1];
            v4u p; p.x = pk2(v0.x, v0.y); p.y = pk2(v0.z, v0.w); p.z = pk2(v1.x, v1.y); p.w = pk2(v1.z, v1.w);
            skb[i] = p;
        }
    }
    for (int m = 4 * gw; m < T; m += 4 * NGW) rows_to_bf16_rs<4, true>(a.in[I_X] + (size_t)m * D, (bf16*)(ws + WS_S0) + (size_t)m * D, (float*)(ws + WS_RS0) + m, F.lane, ws + WS_X8 + (size_t)m * D);
    for (int m = gw; m < MROWS; m += NGW) rows_to_bf16_rs<1, true>(a.in[I_MEM] + (size_t)m * D, (bf16*)a.out + (size_t)m * D, (float*)(ws + WS_RSM) + m, F.lane, (unsigned char*)a.out + 4 * MiB + (size_t)m * D);
}

using pg8::Unit;
typedef pg8::f32x4 A4;
#define EPI_ROWS(u, wr, fr) ((u).pm * 256 + (wr) * 64 + (fr))
DI v4u pack8(const A4& v0, const A4& v1) { v4u w; w.x = pk2(v0[0], v0[1]); w.y = pk2(v0[2], v0[3]); w.z = pk2(v1[0], v1[1]); w.w = pk2(v1[2], v1[3]); return w; }
DI void unpack8(const v4u w, A4& v0, A4& v1) { v0 = (A4){bflo(w.x), bfhi(w.x), bflo(w.y), bfhi(w.y)}; v1 = (A4){bflo(w.z), bfhi(w.z), bflo(w.w), bfhi(w.w)}; }
DI A4 sig4(const A4& v) { return (A4){sigmoidf_(v[0]), sigmoidf_(v[1]), sigmoidf_(v[2]), sigmoidf_(v[3])}; }

struct EpiIn {
    static constexpr bool PERM = true;
    const float* rs0; const float* b1; unsigned char* wsb; int pn_base; float gs;
    DI void operator()(const A4 (&acc)[2][2][4][2], const Unit& u, int wr, int wc, int fr, int fq) const {
        const int pn = u.pn + pn_base, row0 = EPI_ROWS(u, wr, fr), cw = wc * 32 + 8 * fq;
        bf16* const cx = (bf16*)(wsb + WS_S2); bf16* const glu = (bf16*)(wsb + WS_S3);
        if (pn < 4 || pn >= 20) {
            const size_t ooff = pn < 4 ? WS_S1 : (pn < 24 ? WS_S4 : WS_S5);
            bf16* O = (bf16*)(wsb + ooff); const int colt = (pn < 4 ? pn : (pn < 24 ? pn - 20 : pn - 24)) * 256; const bool sg = pn >= 20;
#pragma unroll
            for (int ai = 0; ai < 2; ++ai)
#pragma unroll
                for (int m = 0; m < 4; ++m) { const int r = row0 + ai * 128 + m * 16; const float s = gs;
#pragma unroll
                    for (int bj = 0; bj < 2; ++bj) { A4 v0 = acc[ai][bj][m][0] * s, v1 = acc[ai][bj][m][1] * s; if (sg) { v0 = sig4(v0); v1 = sig4(v1); }
                        __builtin_nontemporal_store(pack8(v0, v1), (GAS v4u*)(O + (size_t)r * D + colt + bj * 128 + cw)); } }
        } else if (pn < 12) {
            const int ch = (pn - 4) * 128 + cw;
#pragma unroll
            for (int ai = 0; ai < 2; ++ai)
#pragma unroll
                for (int m = 0; m < 4; ++m) { const int r = row0 + ai * 128 + m * 16; const float s2 = 1.0f;
                    const A4 v0 = acc[ai][0][m][0] * acc[ai][1][m][0] * s2, v1 = acc[ai][0][m][1] * acc[ai][1][m][1] * s2;
                    __builtin_nontemporal_store(pack8(v0, v1), (GAS v4u*)(cx + (size_t)r * D + ch)); }
        } else {
            const int ch = (pn - 12) * 128 + cw;
            const A4 ba0 = *(const A4*)(b1 + ch), ba1 = *(const A4*)(b1 + ch + 4), bg0 = *(const A4*)(b1 + 1024 + ch), bg1 = *(const A4*)(b1 + 1024 + ch + 4);
#pragma unroll
            for (int ai = 0; ai < 2; ++ai)
#pragma unroll
                for (int m = 0; m < 4; ++m) { const int r = row0 + ai * 128 + m * 16; const float s = gs;
                    const A4 v0 = (acc[ai][0][m][0] * s + ba0) * sig4(acc[ai][1][m][0] * s + bg0), v1 = (acc[ai][0][m][1] * s + ba1) * sig4(acc[ai][1][m][1] * s + bg1);
                    __builtin_nontemporal_store(pack8(v0, v1), (GAS v4u*)(glu + (size_t)r * D + ch)); }
        }
    }
};
struct EpiGate8 {
    static constexpr bool PERM = true;
    unsigned char* wsb;
    DI void operator()(const A4 (&acc)[2][2][4][2], const Unit& u, int wr, int wc, int fr, int fq) const {
        const int pn = u.pn, row0 = EPI_ROWS(u, wr, fr), cw = wc * 32 + 8 * fq;
        bf16* O = (bf16*)(wsb + (pn < 4 ? WS_S4 : WS_S5)); const int colt = (pn & 3) * 256;
#pragma unroll
        for (int ai = 0; ai < 2; ++ai)
#pragma unroll
            for (int m = 0; m < 4; ++m) { const int r = row0 + ai * 128 + m * 16;
#pragma unroll
                for (int bj = 0; bj < 2; ++bj) { const A4 v0 = sig4(acc[ai][bj][m][0] * (1.0f / WG_SCALE)), v1 = sig4(acc[ai][bj][m][1] * (1.0f / WG_SCALE));
                    __builtin_nontemporal_store(pack8(v0, v1), (GAS v4u*)(O + (size_t)r * D + colt + bj * 128 + cw)); } }
    }
};
struct EpiKV {
    static constexpr bool PERM = true;
    const float* rsm; bf16* kb; bf16* vt;
    DI void operator()(const A4 (&acc)[2][2][4][2], const Unit& u, int wr, int wc, int fr, int fq) const {
        const int pn = u.pn, row0 = EPI_ROWS(u, wr, fr), cw = wc * 32 + 8 * fq;
#pragma unroll
        for (int ai = 0; ai < 2; ++ai)
#pragma unroll
            for (int m = 0; m < 4; ++m) { const int r = row0 + ai * 128 + m * 16; const float s = rsm[r];
#pragma unroll
                for (int bj = 0; bj < 2; ++bj) { const A4 v0 = acc[ai][bj][m][0] * s, v1 = acc[ai][bj][m][1] * s;
                    if (pn < 4) *(GAS v4u*)(kb + (size_t)r * D + pn * 256 + bj * 128 + cw) = pack8(v0, v1);
                    else { const int b = r >> 8, key = r & 255, k16 = key & 15, pos = (key & ~15) + 8 * ((k16 >> 2) & 1) + 4 * (k16 >> 3) + (k16 & 3);
                        const int col = (pn - 4) * 256 + bj * 128 + cw; bf16* p = vt + ((size_t)(b * 1024 + col)) * 256 + pos;
#pragma unroll
                        for (int i = 0; i < 4; ++i) { p[(size_t)i * 256] = (bf16)f2bf(v0[i]); p[(size_t)(4 + i) * 256] = (bf16)f2bf(v1[i]); } } } }
    }
};
struct EpiMulGate {
    static constexpr bool PERM = true;
    const bf16* gate; bf16* out;
    DI void operator()(const A4 (&acc)[2][2][4][2], const Unit& u, int wr, int wc, int fr, int fq) const {
        const int row0 = EPI_ROWS(u, wr, fr), c0 = u.pn * 256 + wc * 32 + 8 * fq;
        v4u gv[2][4][2];
#pragma unroll
        for (int ai = 0; ai < 2; ++ai)
#pragma unroll
            for (int m = 0; m < 4; ++m)
#pragma unroll
                for (int bj = 0; bj < 2; ++bj) gv[ai][m][bj] = *(const GAS v4u*)(gate + (size_t)(row0 + ai * 128 + m * 16) * D + c0 + bj * 128);
        __builtin_amdgcn_sched_barrier(0);
#pragma unroll
        for (int ai = 0; ai < 2; ++ai)
#pragma unroll
            for (int m = 0; m < 4; ++m) { const size_t ro = (size_t)(row0 + ai * 128 + m * 16) * D + c0;
#pragma unroll
                for (int bj = 0; bj < 2; ++bj) { A4 g0, g1; unpack8(gv[ai][m][bj], g0, g1);
                    *(GAS v4u*)(out + ro + bj * 128) = pack8(acc[ai][bj][m][0] * g0, acc[ai][bj][m][1] * g1); } }
    }
};
struct EpiMerge {
    static constexpr bool PERM = true;
    const bf16* gate; const bf16* add; const float* bias; bf16* out; float as;
    DI void operator()(const A4 (&acc)[2][2][4][2], const Unit& u, int wr, int wc, int fr, int fq) const {
        const int row0 = EPI_ROWS(u, wr, fr), c0 = u.pn * 256 + wc * 32 + 8 * fq;
        A4 bv[2][2];
#pragma unroll
        for (int bj = 0; bj < 2; ++bj) { bv[bj][0] = *(const A4*)(bias + c0 + bj * 128); bv[bj][1] = *(const A4*)(bias + c0 + bj * 128 + 4); }
#pragma unroll
        for (int ai = 0; ai < 2; ++ai) {
            v4u gv[4][2], tv[4][2];
#pragma unroll
            for (int m = 0; m < 4; ++m)
#pragma unroll
                for (int bj = 0; bj < 2; ++bj) { const size_t ro = (size_t)(row0 + ai * 128 + m * 16) * D + c0 + bj * 128; gv[m][bj] = *(const GAS v4u*)(gate + ro); tv[m][bj] = *(const GAS v4u*)(add + ro); }
            __builtin_amdgcn_sched_barrier(0);
#pragma unroll
            for (int m = 0; m < 4; ++m) { const size_t ro = (size_t)(row0 + ai * 128 + m * 16) * D + c0;
#pragma unroll
                for (int bj = 0; bj < 2; ++bj) { A4 g0, g1, t0, t1; unpack8(gv[m][bj], g0, g1); unpack8(tv[m][bj], t0, t1);
                    *(GAS v4u*)(out + ro + bj * 128) = pack8(t0 + (acc[ai][bj][m][0] * as + bv[bj][0]) * g0, t1 + (acc[ai][bj][m][1] * as + bv[bj][1]) * g1); } }
        }
    }
};
template <bool BF> struct EpiResid {
    static constexpr bool PERM = true;
    const void* base; bf16* out; unsigned long long* ss;
    DI void operator()(const A4 (&acc)[2][2][4][2], const Unit& u, int wr, int wc, int fr, int fq) const {
        const int row0 = EPI_ROWS(u, wr, fr), c0 = u.pn * 256 + wc * 32 + 8 * fq;
#pragma unroll
        for (int ai = 0; ai < 2; ++ai) {
            A4 bb[4][2][2];
#pragma unroll
            for (int m = 0; m < 4; ++m)
#pragma unroll
                for (int bj = 0; bj < 2; ++bj) { const size_t ro = (size_t)(row0 + ai * 128 + m * 16) * D + c0 + bj * 128;
                    if (BF) unpack8(*(const GAS v4u*)((const bf16*)base + ro), bb[m][bj][0], bb[m][bj][1]);
                    else { bb[m][bj][0] = __builtin_nontemporal_load((const GAS A4*)((const float*)base + ro)); bb[m][bj][1] = __builtin_nontemporal_load((const GAS A4*)((const float*)base + ro + 4)); } }
            __builtin_amdgcn_sched_barrier(0);
#pragma unroll
            for (int m = 0; m < 4; ++m) { const int r = row0 + ai * 128 + m * 16; const size_t ro = (size_t)r * D + c0; float q = 0.f;
#pragma unroll
                for (int bj = 0; bj < 2; ++bj) { const A4 b0 = bb[m][bj][0], b1 = bb[m][bj][1];
                    const A4 v0 = b0 + acc[ai][bj][m][0], v1 = b1 + acc[ai][bj][m][1];
                    q += (v0[0] * v0[0] + v0[1] * v0[1]) + (v0[2] * v0[2] + v0[3] * v0[3]) + (v1[0] * v1[0] + v1[1] * v1[1]) + (v1[2] * v1[2] + v1[3] * v1[3]);
                    *(GAS v4u*)(out + ro + bj * 128) = pack8(v0, v1); }
                q += __shfl_xor(q, 16); q += __shfl_xor(q, 32);
                if (fq == 0) atomicAdd(ss + r, (unsigned long long)(q * SS_FIX + 0.5f)); }
        }
    }
};
struct EpiResidN {
    static constexpr bool PERM = true;
    const bf16* xn; const float* rs; bf16* out; unsigned long long* ss; unsigned char* o8; float as;
    DI void operator()(const A4 (&acc)[2][2][4][2], const Unit& u, int wr, int wc, int fr, int fq) const {
        const int row0 = EPI_ROWS(u, wr, fr), c0 = u.pn * 256 + wc * 32 + 8 * fq;
        v4u xv[2][4][2]; float rv[2][4];
#pragma unroll
        for (int ai = 0; ai < 2; ++ai)
#pragma unroll
            for (int m = 0; m < 4; ++m) { const int r = row0 + ai * 128 + m * 16; rv[ai][m] = rs ? rs[r] : 1.0f;
#pragma unroll
                for (int bj = 0; bj < 2; ++bj) xv[ai][m][bj] = *(const GAS v4u*)(xn + (size_t)r * D + c0 + bj * 128); }
        __builtin_amdgcn_sched_barrier(0);
#pragma unroll
        for (int ai = 0; ai < 2; ++ai)
#pragma unroll
            for (int m = 0; m < 4; ++m) { const int r = row0 + ai * 128 + m * 16; const size_t ro = (size_t)r * D + c0; float q = 0.f; const float rms = 1.0f / rv[ai][m];
#pragma unroll
                for (int bj = 0; bj < 2; ++bj) { A4 b0, b1; unpack8(xv[ai][m][bj], b0, b1);
                    const A4 v0 = b0 * rms + acc[ai][bj][m][0] * as, v1 = b1 * rms + acc[ai][bj][m][1] * as;
                    q += (v0[0] * v0[0] + v0[1] * v0[1]) + (v0[2] * v0[2] + v0[3] * v0[3]) + (v1[0] * v1[0] + v1[1] * v1[1]) + (v1[2] * v1[2] + v1[3] * v1[3]);
                    *(GAS v4u*)(out + ro + bj * 128) = pack8(v0, v1);
                    if (o8) { int w0 = 0, w1 = 0; w0 = __builtin_amdgcn_cvt_pk_fp8_f32(v0[0], v0[1], w0, false); w0 = __builtin_amdgcn_cvt_pk_fp8_f32(v0[2], v0[3], w0, true);
                        w1 = __builtin_amdgcn_cvt_pk_fp8_f32(v1[0], v1[1], w1, false); w1 = __builtin_amdgcn_cvt_pk_fp8_f32(v1[2], v1[3], w1, true);
                        *(GAS v2u*)(o8 + ro + bj * 128) = (v2u){(unsigned)w0, (unsigned)w1}; } }
                { const int ln = fr | (fq << 4);
                  q += __builtin_bit_cast(float, __builtin_amdgcn_ds_bpermute((ln ^ 16) << 2, __builtin_bit_cast(int, q))); q += __builtin_bit_cast(float, __builtin_amdgcn_ds_bpermute((ln ^ 32) << 2, __builtin_bit_cast(int, q))); }
                if (fq == 0) atomicAdd(ss + r, (unsigned long long)(q * SS_FIX + 0.5f)); }
    }
};
struct EpiRowScale {
    static constexpr bool PERM = true;
    const unsigned long long* ss; bf16* out; int ldc; float scale;
    DI void operator()(const A4 (&acc)[2][2][4][2], const Unit& u, int wr, int wc, int fr, int fq) const {
        const int row0 = EPI_ROWS(u, wr, fr), c0 = u.pn * 256 + wc * 32 + 8 * fq;
#pragma unroll
        for (int ai = 0; ai < 2; ++ai)
#pragma unroll
            for (int m = 0; m < 4; ++m) { const int r = row0 + ai * 128 + m * 16; const float s = scale / sqrtf(ss_get(ss, r) * (1.0f / D) + EPS); const size_t ro = (size_t)r * ldc + c0;
#pragma unroll
                for (int bj = 0; bj < 2; ++bj) *(GAS v4u*)(out + ro + bj * 128) = pack8(acc[ai][bj][m][0] * s, acc[ai][bj][m][1] * s); }
    }
};

struct EpiQFrag {
    static constexpr bool PERM = true;
    const unsigned long long* ss; bf16* out; float scale;
    DI void operator()(const A4 (&acc)[2][2][4][2], const Unit& u, int wr, int wc, int fr, int fq) const {
        const int row0 = EPI_ROWS(u, wr, fr), cw = wc * 32 + 8 * fq;
#pragma unroll
        for (int ai = 0; ai < 2; ++ai)
#pragma unroll
            for (int m = 0; m < 4; ++m) { const int r = row0 + ai * 128 + m * 16;
#pragma unroll
                for (int bj = 0; bj < 2; ++bj) { const int c = cw + bj * 128;
                    *(GAS v4u*)(out + ((size_t)((((r >> 5) * 4 + u.pn) * 32 + (c >> 3)) * 32 + (r & 31))) * 8) = pack8(acc[ai][bj][m][0] * scale, acc[ai][bj][m][1] * scale); } }
    }
};

struct EpiPQFrag {
    static constexpr bool PERM = true;
    const unsigned long long* ss; bf16* out;
    DI void operator()(const A4 (&acc)[2][2][4][2], const Unit& u, int wr, int wc, int fr, int fq) const {
        const int row0 = EPI_ROWS(u, wr, fr), cw = wc * 32 + 8 * fq;
#pragma unroll
        for (int ai = 0; ai < 2; ++ai)
#pragma unroll
            for (int m = 0; m < 4; ++m) { const int r = row0 + ai * 128 + m * 16;
#pragma unroll
                for (int bj = 0; bj < 2; ++bj)
                    *(GAS v4u*)(out + ((size_t)((((((r >> 5) * 8 + u.pn) * 2 + bj) * 16 + (cw >> 3)) * 32) + (r & 31))) * 8) = pack8(acc[ai][bj][m][0], acc[ai][bj][m][1]); }
    }
};

DI void kv_gemm(const Args& a, const Ctx& F) {
    unsigned char* ws = a.ws;
    const float* rsm = (const float*)(ws + WS_RSM); bf16* kb = (bf16*)(ws + WS_KB); bf16* vt = (bf16*)(ws + WS_VT);
    LAS unsigned char* lds = F.lds + RING_OFF;
    const int lane = F.lane, wave = F.wave, wm = wave >> 2, wn = wave & 3, fr = lane & 15, fq = lane >> 4;
    const int R0 = 8 * wave + (lane >> 3), csrc = (lane & 7) ^ ((R0 >> 1) & 7);
    const unsigned goff = (unsigned)(R0 * D + 16 * csrc);
    const int swz = (fr >> 1) & 7;
    const unsigned fo0 = (unsigned)((fq ^ swz) << 4), fo1 = (unsigned)(((4 + fq) ^ swz) << 4);
    const unsigned abase = (unsigned)((64 * wm + fr) * 128), bbase = 16384u + (unsigned)((32 * wn + fr) * 128);
#define KV_J8(x0_, x1_) __builtin_shufflevector(__builtin_bit_cast(pg8::i32x4_t, x0_), __builtin_bit_cast(pg8::i32x4_t, x1_), 0, 1, 2, 3, 4, 5, 6, 7)
#define KV_STAGE(st, kt) do { const char* pa_ = gA + (size_t)(kt) * 128 + goff; const char* pb_ = gB + (size_t)(kt) * 128 + goff; LAS unsigned char* sb_ = lds + (st) * 32768 + wave * 1024; \
        __builtin_amdgcn_global_load_lds((const unsigned*)pa_, (LAS unsigned*)sb_, 16, 0, 0); __builtin_amdgcn_global_load_lds((const unsigned*)(pa_ + 64 * D), (LAS unsigned*)(sb_ + 8192), 16, 0, 0); \
        __builtin_amdgcn_global_load_lds((const unsigned*)pb_, (LAS unsigned*)(sb_ + 16384), 16, 0, 0); __builtin_amdgcn_global_load_lds((const unsigned*)(pb_ + 64 * D), (LAS unsigned*)(sb_ + 24576), 16, 0, 0); } while (0)
    __builtin_amdgcn_s_waitcnt(0xF70);
    for (int tile = F.vcu; tile < 256; tile += F.G) {
        const int m0 = (tile >> 4) * 128, n0 = (tile & 15) * 128; const bool vpart = n0 >= 1024;
        const char* gA = (const char*)a.out + 4 * MiB + (size_t)m0 * D; const char* gB = (const char*)(ws + WS_WQ) + (size_t)n0 * D;
        pg8::f32x4 acc[4][2];
#pragma unroll
        for (int mi = 0; mi < 4; ++mi)
#pragma unroll
            for (int ni = 0; ni < 2; ++ni) acc[mi][ni] = (pg8::f32x4){0.f, 0.f, 0.f, 0.f};
        KV_STAGE(0, 0); KV_STAGE(1, 1); KV_STAGE(2, 2);
#pragma unroll 1
        for (int kt = 0; kt < 8; ++kt) {
            if (kt <= 5) __builtin_amdgcn_s_waitcnt(0xF78); else if (kt == 6) __builtin_amdgcn_s_waitcnt(0xF74); else __builtin_amdgcn_s_waitcnt(0xF70);
            asm volatile("" ::: "memory"); __builtin_amdgcn_s_barrier(); asm volatile("" ::: "memory");
            const LAS unsigned char* sb = lds + (kt & 3) * 32768;
            bf16x8 af[4][2], bfr[2][2];
#pragma unroll
            for (int mi = 0; mi < 4; ++mi) { af[mi][0] = *(const LAS bf16x8*)(sb + abase + mi * 2048 + fo0); af[mi][1] = *(const LAS bf16x8*)(sb + abase + mi * 2048 + fo1); }
#pragma unroll
            for (int ni = 0; ni < 2; ++ni) { bfr[ni][0] = *(const LAS bf16x8*)(sb + bbase + ni * 2048 + fo0); bfr[ni][1] = *(const LAS bf16x8*)(sb + bbase + ni * 2048 + fo1); }
            if (vpart) {
#pragma unroll
                for (int mi = 0; mi < 4; ++mi)
#pragma unroll
                    for (int ni = 0; ni < 2; ++ni)
#pragma unroll
                        for (int ks = 0; ks < 1; ++ks) acc[mi][ni] = __builtin_amdgcn_mfma_scale_f32_16x16x128_f8f6f4(KV_J8(af[mi][0], af[mi][1]), KV_J8(bfr[ni][0], bfr[ni][1]), acc[mi][ni], 0, 0, 0, 0, 0, 0);
            } else {
#pragma unroll
                for (int mi = 0; mi < 4; ++mi)
#pragma unroll
                    for (int ni = 0; ni < 2; ++ni)
#pragma unroll
                        for (int ks = 0; ks < 1; ++ks) acc[mi][ni] = __builtin_amdgcn_mfma_scale_f32_16x16x128_f8f6f4(KV_J8(bfr[ni][0], bfr[ni][1]), KV_J8(af[mi][0], af[mi][1]), acc[mi][ni], 0, 0, 0, 0, 0, 0);
            }
            __builtin_amdgcn_sched_barrier(0);
            if (kt + 3 < 8) KV_STAGE((kt + 3) & 3, kt + 3);
        }
        if (!vpart) {
#pragma unroll
            for (int mi = 0; mi < 4; ++mi) { const int m = m0 + 64 * wm + 16 * mi + fr; const float s = 1.0f / WG_SCALE;
#pragma unroll
                for (int ni = 0; ni < 2; ++ni) { const pg8::f32x4 v = acc[mi][ni] * s;
                    *(GAS v2u*)(kb + (size_t)m * D + n0 + 32 * wn + 16 * ni + 4 * fq) = (v2u){pk2(v[0], v[1]), pk2(v[2], v[3])}; } }
        } else {
#pragma unroll
            for (int mi = 0; mi < 4; ++mi) { const int mb = m0 + 64 * wm + 16 * mi, b = mb >> 8, key0 = mb & 255; const pg8::f32x4 s4 = (pg8::f32x4){1.f / WG_SCALE, 1.f / WG_SCALE, 1.f / WG_SCALE, 1.f / WG_SCALE};
#pragma unroll
                for (int ni = 0; ni < 2; ++ni) { const pg8::f32x4 v = acc[mi][ni] * s4; const int col = n0 - 1024 + 32 * wn + 16 * ni + fr;
                    *(GAS v2u*)(vt + (size_t)(b * 1024 + col) * 256 + key0 + 8 * (fq & 1) + 4 * (fq >> 1)) = (v2u){pk2(v[0], v[1]), pk2(v[2], v[3])}; } }
        }
        __builtin_amdgcn_s_waitcnt(0xF70);
        __syncthreads();
    }
#undef KV_STAGE
#undef KV_J8
}

constexpr int TS = 16, RUNLEN = 128;
template <int K, int I> DI void conv_one(f32x2 (&acc)[TS], const f32x2 (&w)[31], const f32x2 x) { if constexpr (K - I >= 0 && K - I <= 30) acc[I] += w[K - I] * x; }
template <int K, int... Is> DI void conv_row(f32x2 (&acc)[TS], const f32x2 (&w)[31], const f32x2 x, std::integer_sequence<int, Is...>) { (conv_one<K, Is>(acc, w, x), ...); }
template <int... Ks> DI void conv_all(f32x2 (&acc)[TS], const f32x2 (&w)[31], const unsigned (&win)[TS + 30], std::integer_sequence<int, Ks...>) {
    (conv_row<Ks>(acc, w, (f32x2){bflo(win[Ks]), bfhi(win[Ks])}, std::make_integer_sequence<int, TS>{}), ...); }
DI void conv_phase(const Args& a, const Ctx& F) {
    unsigned char* ws = a.ws;
    const GAS unsigned* SCB = (const GAS unsigned*)(ws + WS_S1); const GAS unsigned* CX = (const GAS unsigned*)(ws + WS_S2); const GAS unsigned* GLU = (const GAS unsigned*)(ws + WS_S3);
    GAS unsigned* YSC = (GAS unsigned*)a.out; GAS unsigned short* CFA8 = (GAS unsigned short*)(ws + WS_X8);
    const int tid = F.tid, lane = F.lane, wave = F.wave;
    LAS float* red = (LAS float*)(F.lds + RING_OFF);
    f32x2 w31[31];
#pragma unroll
    for (int j = 0; j < 31; ++j) w31[j] = *(const f32x2*)(a.in[I_CFCW] + j * D + 2 * tid);
    const f32x2 w3a = *(const f32x2*)(a.in[I_SCCW] + 2 * tid), w3b = *(const f32x2*)(a.in[I_SCCW] + D + 2 * tid), w3c = *(const f32x2*)(a.in[I_SCCW] + 2 * D + 2 * tid);
    const f32x2 cb = *(const f32x2*)(a.in[I_CFCB] + 2 * tid), lg = *(const f32x2*)(a.in[I_LNG] + 2 * tid), lb = *(const f32x2*)(a.in[I_LNB] + 2 * tid);
    for (int run = F.vcu; run < T / RUNLEN; run += F.G) {
        const int t0 = run * RUNLEN; const bool first = (t0 & (SEQ - 1)) == 0; const unsigned hmask = first ? 0u : 0xffffffffu;
        unsigned win[TS + 30], gn[TS], cs[TS], sb[TS];
#pragma unroll
        for (int k = 0; k < TS + 30; ++k) { const int row = (k < 30 && first) ? t0 : t0 - 30 + k; const unsigned w = GLU[(size_t)row * 512 + tid]; win[k] = (k < 30) ? (w & hmask) : w; }
        const int rh = first ? t0 : t0 - 2;
        unsigned c0 = CX[(size_t)rh * 512 + tid] & hmask, c1 = CX[(size_t)(rh + (first ? 0 : 1)) * 512 + tid] & hmask;
#pragma unroll
        for (int k = 0; k < TS; ++k) { cs[k] = CX[(size_t)(t0 + k) * 512 + tid]; sb[k] = SCB[(size_t)(t0 + k) * 512 + tid]; }
#pragma unroll
        for (int k = 0; k < TS; ++k) gn[k] = GLU[(size_t)(t0 + TS + k) * 512 + tid];
#pragma unroll 1
        for (int s = 0; s < RUNLEN / TS; ++s) {
            const int ts = t0 + s * TS;
            f32x2 acc[TS];
#pragma unroll
            for (int i = 0; i < TS; ++i) acc[i] = cb;
            conv_all(acc, w31, win, std::make_integer_sequence<int, TS + 30>{});
#pragma unroll
            for (int k = 0; k < 30; ++k) win[k] = win[k + TS];
#pragma unroll
            for (int k = 0; k < TS; ++k) win[30 + k] = gn[k];
            if (s + 2 < RUNLEN / TS) {
#pragma unroll
                for (int k = 0; k < TS; ++k) gn[k] = GLU[(size_t)(ts + 2 * TS + k) * 512 + tid];
            }
            float v[32];
#pragma unroll
            for (int i = 0; i < TS; ++i) { const f32x2 x = acc[i]; v[i] = x.x + x.y; v[16 + i] = x.x * x.x + x.y * x.y; }
            const float r = treduce<32, 5>(v, lane);
            LAS float* rb = red + (s & 1) * 256;
            if ((lane & 1) == 0) rb[wave * 32 + (lane >> 1)] = r;
            LDS_WAIT(); __builtin_amdgcn_s_barrier(); asm volatile("" ::: "memory");
            float tot = 0.f;
#pragma unroll
            for (int w = 0; w < 8; ++w) tot += rb[w * 32 + (lane & 31)];
#pragma unroll
            for (int i = 0; i < TS; ++i) {
                const float mean = __builtin_bit_cast(float, __builtin_amdgcn_readlane(__builtin_bit_cast(int, tot), i)) * (1.0f / D);
                const float ex2 = __builtin_bit_cast(float, __builtin_amdgcn_readlane(__builtin_bit_cast(int, tot), 16 + i)) * (1.0f / D);
                const float rstd = 1.0f / sqrtf(fmaxf(ex2 - mean * mean, 0.f) + EPS);
                const f32x2 y = (acc[i] - mean) * rstd * lg + lb;
                const float o0 = y.x * sigmoidf_(y.x), o1 = y.y * sigmoidf_(y.y);
                CFA8[(size_t)(ts + i) * 512 + tid] = (unsigned short)__builtin_amdgcn_cvt_pk_fp8_f32(o0, o1, 0, false);
            }
#pragma unroll
            for (int i = 0; i < TS; ++i) {
                const unsigned c2 = cs[i];
                const f32x2 x0 = (f32x2){bflo(c0), bfhi(c0)}, x1 = (f32x2){bflo(c1), bfhi(c1)}, x2 = (f32x2){bflo(c2), bfhi(c2)};
                const f32x2 cv = w3a * x0 + w3b * x1 + w3c * x2;
                YSC[(size_t)(ts + i) * 512 + tid] = pk2(bflo(sb[i]) * cv.x, bfhi(sb[i]) * cv.y);
                c0 = c1; c1 = c2;
            }
            if (s + 1 < RUNLEN / TS) {
#pragma unroll
                for (int k = 0; k < TS; ++k) { cs[k] = CX[(size_t)(ts + TS + k) * 512 + tid]; sb[k] = SCB[(size_t)(ts + TS + k) * 512 + tid]; }
            }
        }
    }
}

typedef _Float16 h2_t __attribute__((ext_vector_type(2)));
#define MFMA32(a, b, c) __builtin_amdgcn_mfma_f32_32x32x16_bf16((a), (b), (c), 0, 0, 0)
DI int crow(int reg, int h) { return (reg & 3) + 8 * (reg >> 2) + 4 * h; }
DI bf16x8 pack_frag(const f32x16& x, int s) {
    v4u p; p.x = pk2(x[8 * s + 0], x[8 * s + 1]); p.y = pk2(x[8 * s + 2], x[8 * s + 3]); p.z = pk2(x[8 * s + 4], x[8 * s + 5]); p.w = pk2(x[8 * s + 6], x[8 * s + 7]);
    return __builtin_bit_cast(bf16x8, p);
}
template <int I0, int N> DI void attn_stage_load(v4u (&tmp)[16], const bf16* src, size_t row_stride, int tid) {
    const unsigned off0 = (unsigned)(((tid >> 5) * (int)row_stride + 8 * (tid & 31)) * 2);
#pragma unroll
    for (int i = I0; i < I0 + N; ++i) tmp[i] = *(const GAS v4u*)((const GAS char*)src + (size_t)i * 32 * row_stride + off0);
}
template <int I0, int N> DI void attn_stage_store(LAS unsigned char* kl, const v4u (&tmp)[16], int tid) {
#pragma unroll
    for (int i = I0; i < I0 + N; ++i) { const int id = tid + 512 * i, row = id >> 5, c = id & 31; *(LAS v4u*)(kl + row * 512 + ((c ^ (row & 15)) << 4)) = tmp[i]; }
    asm volatile("" ::: "memory");
}
DI void attn_phase(const Args& a, const Ctx& F) {
    unsigned char* ws = a.ws;
    const bf16* QB = (const bf16*)(ws + WS_S3); const bf16* KB = (const bf16*)(ws + WS_KB); const bf16* VT = (const bf16*)(ws + WS_VT); bf16* OB = (bf16*)(ws + WS_S4); unsigned char* O8 = ws + WS_S1;
    const int lane = F.lane, r = lane & 31, hh = lane >> 5;
    LAS unsigned char* kl = F.lds + RING_OFF;
    LAS unsigned char* ot = F.lds + ZACC_OFF + F.wave * 2560;
    pg8::StaticOrder SO; SO.init(T, D, F.G, (int)blockIdx.x);
    pg8::Unit cu, nu; bool have = SO.next(0, cu);
    v4u st[16];
    if (have) attn_stage_load<0, 16>(st, KB + (size_t)((cu.pm >> 4) * NMEM) * D + cu.pn * 256, D, F.tid);
    for (int ui = 0; have; ++ui) {
        const bool hasn = SO.next(ui + 1, nu);
        const int b = cu.pm >> 4, h = cu.pn, qt = cu.pm & 15;
        const int t0 = b * SEQ + qt * 256 + F.wave * 32;
        const bf16* qp = QB + ((size_t)(((t0 >> 5) * 4 + h) * 32 + hh) * 32 + r) * 8;
        bf16x8 qf[16];
#pragma unroll
        for (int kk = 0; kk < 16; ++kk) qf[kk] = *(const GAS bf16x8*)(qp + 512 * kk);
        __syncthreads();
        attn_stage_store<0, 16>(kl, st, F.tid);
        attn_stage_load<0, 8>(st, VT + (size_t)(b * 1024 + h * 256) * 256, 256, F.tid);
        __syncthreads();
        const int sw = r & 15;
        const LAS unsigned char* kb0 = kl + r * 512 + ((hh ^ (sw & 1)) << 4); const int kc = sw >> 1;
#define KBASE(k7) (kb0 + (((k7) ^ kc) << 5))
        float mx = -3.0e38f;
        h2_t s16[8][8];
#pragma unroll
        for (int kb = 0; kb < 8; ++kb) {
            f32x16 acc;
#pragma unroll
            for (int i = 0; i < 16; ++i) acc[i] = 0.f;
#pragma unroll
            for (int kk = 0; kk < 16; ++kk) { const bf16x8 kf = *(const LAS bf16x8*)(KBASE(kk & 7) + kb * 16384 + (kk >> 3) * 256); acc = MFMA32(kf, qf[kk], acc); if ((kk & 7) == 7) asm volatile("" ::: "memory"); }
#pragma unroll
            for (int i = 0; i < 16; ++i) mx = __builtin_fmaxf(mx, acc[i]);
#pragma unroll
            for (int j = 0; j < 8; ++j) s16[kb][j] = __builtin_convertvector((f32x2){acc[2 * j], acc[2 * j + 1]}, h2_t);
        }
        mx = __builtin_fmaxf(mx, __shfl_xor(mx, 32));
        const float qs = 1.0f / sqrtf(ss_get((const unsigned long long*)(ws + WS_SS1), t0 + r) * (1.0f / D) + EPS);
        attn_stage_load<8, 8>(st, VT + (size_t)(b * 1024 + h * 256) * 256, 256, F.tid);
        float l = 0.f;
        bf16x8 pf[8][2];
#pragma unroll
        for (int kb = 0; kb < 8; ++kb) {
            f32x16 acc;
#pragma unroll
            for (int j = 0; j < 8; ++j) { const f32x2 sv = __builtin_convertvector(s16[kb][j], f32x2);
                const float p0 = __builtin_amdgcn_exp2f((sv.x - mx) * qs), p1 = __builtin_amdgcn_exp2f((sv.y - mx) * qs); acc[2 * j] = p0; acc[2 * j + 1] = p1; l += p0 + p1; }
            pf[kb][0] = pack_frag(acc, 0); pf[kb][1] = pack_frag(acc, 1);
        }
        l += __shfl_xor(l, 32);
        const float inv = 1.0f / l;
        __syncthreads();
        attn_stage_store<0, 16>(kl, st, F.tid);
        if (hasn) attn_stage_load<0, 16>(st, KB + (size_t)((nu.pm >> 4) * NMEM) * D + nu.pn * 256, D, F.tid);
        __syncthreads();
        int r2 = r; asm volatile("" : "+v"(r2));
        const LAS unsigned char* vbase[8];
#pragma unroll
        for (int k7 = 0; k7 < 8; ++k7) vbase[k7] = kl + r2 * 512 + (((4 * (k7 >> 1) + 2 * (k7 & 1) + hh) ^ (r2 & 15)) << 4);
        unsigned char* op8 = O8 + (size_t)t0 * D + h * 256;
#pragma unroll 1
        for (int db = 0; db < 8; ++db) {
            f32x16 acc;
#pragma unroll
            for (int i = 0; i < 16; ++i) acc[i] = 0.f;
#pragma unroll
            for (int kb = 0; kb < 8; ++kb)
#pragma unroll
                for (int s = 0; s < 2; ++s) { const bf16x8 vf = *(const LAS bf16x8*)(vbase[(kb & 3) * 2 + s] + db * 16384 + (kb >> 2) * 256); acc = MFMA32(vf, pf[kb][s], acc); if (s == 1 && (kb & 3) == 3) asm volatile("" ::: "memory"); }
#pragma unroll
            for (int g = 0; g < 4; ++g) { int e = 0; e = __builtin_amdgcn_cvt_pk_fp8_f32(acc[4 * g] * inv, acc[4 * g + 1] * inv, e, false); e = __builtin_amdgcn_cvt_pk_fp8_f32(acc[4 * g + 2] * inv, acc[4 * g + 3] * inv, e, true);
                *(LAS unsigned*)(ot + r * 48 + 8 * g + 4 * hh) = (unsigned)e; }
            { const int row = lane >> 1; const v4u w = *(const LAS v4u*)(ot + row * 48 + 16 * (lane & 1));
                *(GAS v4u*)(op8 + (size_t)row * D + 32 * db + 16 * (lane & 1)) = w; }
        }
        have = hasn; cu = nu;
    }
#undef KBASE
}

template <int N, int LOGN> DI void bsort_desc(float (&v)[N]) {
#pragma unroll
    for (int ks = 1; ks <= LOGN; ++ks) {
#pragma unroll
        for (int js = ks - 1; js >= 0; --js) {
#pragma unroll
            for (int i = 0; i < N; ++i) {
                const int j = 1 << js, k = 1 << ks, l = i ^ j;
                if (l > i) { const bool up = (i & k) != 0 && ks < LOGN; const float x = v[i], y = v[l]; const float hi = fmax_(x, y), lo = fmin_(x, y); v[i] = up ? lo : hi; v[l] = up ? hi : lo; }
            }
        }
    }
}
DI void merge_top16(float (&a)[16], const float (&b)[16]) {
#pragma unroll
    for (int i = 0; i < 16; ++i) a[i] = fmax_(a[i], b[15 - i]);
#pragma unroll
    for (int js = 3; js >= 0; --js) {
#pragma unroll
        for (int i = 0; i < 16; ++i) { const int j = 1 << js, l = i ^ j; if (l > i) { const float x = a[i], y = a[l]; a[i] = fmax_(x, y); a[l] = fmin_(x, y); } }
    }
}
DI float embed_lo(float v, unsigned mask, unsigned payload) { return __builtin_bit_cast(float, (__builtin_bit_cast(unsigned, v) & ~mask) | payload); }
#define SN_CE(i, j) { const float x_ = v[i], y_ = v[j]; v[i] = fmax_(x_, y_); v[j] = fmin_(x_, y_); }
DI void sort16_desc(float (&v)[16]) {
    SN_CE(0, 13) SN_CE(1, 12) SN_CE(2, 15) SN_CE(3, 14) SN_CE(4, 8) SN_CE(5, 6) SN_CE(7, 11) SN_CE(9, 10)
    SN_CE(0, 5) SN_CE(1, 7) SN_CE(2, 9) SN_CE(3, 4) SN_CE(6, 13) SN_CE(8, 14) SN_CE(10, 15) SN_CE(11, 12)
    SN_CE(0, 1) SN_CE(2, 3) SN_CE(4, 5) SN_CE(6, 8) SN_CE(7, 9) SN_CE(10, 11) SN_CE(12, 13) SN_CE(14, 15)
    SN_CE(0, 2) SN_CE(1, 3) SN_CE(4, 10) SN_CE(5, 11) SN_CE(6, 7) SN_CE(8, 9) SN_CE(12, 14) SN_CE(13, 15)
    SN_CE(1, 2) SN_CE(3, 12) SN_CE(4, 6) SN_CE(5, 7) SN_CE(8, 10) SN_CE(9, 11) SN_CE(13, 14)
    SN_CE(1, 4) SN_CE(2, 6) SN_CE(5, 8) SN_CE(7, 10) SN_CE(9, 13) SN_CE(11, 14)
    SN_CE(2, 4) SN_CE(3, 6) SN_CE(9, 12) SN_CE(11, 13)
    SN_CE(3, 5) SN_CE(6, 8) SN_CE(7, 9) SN_CE(10, 12)
    SN_CE(3, 4) SN_CE(5, 6) SN_CE(7, 8) SN_CE(9, 10) SN_CE(11, 12)
    SN_CE(6, 7) SN_CE(8, 9)
}
#undef SN_CE
DI void sub_top16h(float (&top)[16], const bf16* qrow, const LAS unsigned char* skl, int r, int hh) {
    bf16x8 qf[8];
#pragma unroll
    for (int kk = 0; kk < 8; ++kk) qf[kk] = *(const GAS bf16x8*)(qrow + 512 * kk);
#pragma unroll
    for (int i = 0; i < 16; ++i) top[i] = -3.0e38f;
#pragma unroll 1
    for (int kb = 0; kb < 4; ++kb) {
        f32x16 acc;
#pragma unroll
        for (int i = 0; i < 16; ++i) acc[i] = 0.f;
        const int row = 32 * kb + r;
#pragma unroll
        for (int kk = 0; kk < 8; ++kk) { const bf16x8 sf = *(const LAS bf16x8*)(skl + row * 256 + (((2 * kk + hh) ^ (row & 15)) << 4)); acc = MFMA32(sf, qf[kk], acc); }
        float g[16];
#pragma unroll
        for (int i = 0; i < 16; ++i) g[i] = embed_lo(acc[i], 127u, (unsigned)(32 * kb + crow(i, hh)));
        sort16_desc(g);
        if (kb == 0) {
#pragma unroll
            for (int i = 0; i < 16; ++i) top[i] = g[i];
        } else merge_top16(top, g);
    }
}
DI void sub_top16_pair(float (&s)[16], const bf16* qA, const bf16* qB, const LAS unsigned char* skl, int r, int hh) {
    float ta[16], tb[16];
    sub_top16h(ta, qA, skl, r, hh);
    sub_top16h(tb, qB, skl, r, hh);
    float o[16];
#pragma unroll
    for (int i = 0; i < 16; ++i) { const float mine = hh ? tb[i] : ta[i], give = hh ? ta[i] : tb[i]; o[i] = __shfl_xor(give, 32); s[i] = mine; }
    merge_top16(s, o);
}
DI void route_phase(const Args& a, const Ctx& F) {
    unsigned char* ws = a.ws;
    const bf16* PQ = (const bf16*)a.out; const bf16* SKB = (const bf16*)(ws + WS_SKB);
    int* EIDX = (int*)(ws + WS_S0); float* GATE = (float*)(ws + WS_S0 + 16 * MiB);
    const int lane = F.lane, r = lane & 31, hh = lane >> 5;
    LAS unsigned* T1 = (LAS unsigned*)(F.lds + RING_OFF + F.wave * 8192);
    LAS unsigned* T2 = T1 + 1024;
    LAS unsigned char* skl = F.lds + RING_OFF + 65536;
    for (int id = F.tid; id < 4096; id += NWAVES * 64) { const int row = id >> 4, c = id & 15;
        *(LAS v4u*)(skl + row * 256 + ((c ^ (row & 15)) << 4)) = *(const GAS v4u*)(SKB + (size_t)id * 8); }
    __syncthreads();
    const int gw = F.vcu * NWAVES + F.wave, NGW = F.G * NWAVES;
    for (int dt = gw; dt < T / 8; dt += NGW) {
        const int blk = dt >> 2, head = 2 * (dt & 3) + hh;
        const float rsl = LOG2E / sqrtf(ss_get((const unsigned long long*)(ws + WS_SS2), blk * 32 + r) * (1.0f / D) + EPS);
        const bf16* qA = PQ + ((size_t)(blk * 8 + 2 * (dt & 3)) * 2 * 16 * 32 + hh * 32 + r) * 8; const bf16* qB = qA + 2 * 16 * 32 * 8;
        float sa[16], sb[16];
        sub_top16_pair(sa, qA, qB, skl, r, hh);
        sub_top16_pair(sb, qA + 16 * 32 * 8, qB + 16 * 32 * 8, skl + 32768, r, hh);
#pragma unroll
        for (int i = 0; i < 16; ++i) { T1[i * 64 + lane] = __builtin_bit_cast(unsigned, sa[i]) & 127u; T2[i * 64 + lane] = __builtin_bit_cast(unsigned, sb[i]) & 127u; }
        float tc[16];
#define CAND(A, B) embed_lo(sa[A] + sb[B], 255u, (unsigned)(((A) << 4) | (B)))
        {
#pragma unroll
            for (int i = 0; i < 16; ++i) tc[i] = CAND(0, i);
            float c[16];
#pragma unroll
            for (int i = 0; i < 8; ++i) c[i] = CAND(1, i);
#pragma unroll
            for (int i = 0; i < 5; ++i) c[8 + i] = CAND(2, i);
#pragma unroll
            for (int i = 0; i < 3; ++i) c[13 + i] = CAND(3, i);
            sort16_desc(c); merge_top16(tc, c);
            c[0] = CAND(3, 3);
#pragma unroll
            for (int i = 0; i < 3; ++i) c[1 + i] = CAND(4, i);
#pragma unroll
            for (int i = 0; i < 2; ++i) { c[4 + i] = CAND(5, i); c[6 + i] = CAND(6, i); c[8 + i] = CAND(7, i); }
#pragma unroll
            for (int i = 0; i < 6; ++i) c[10 + i] = CAND(8 + i, 0);
            sort16_desc(c); merge_top16(tc, c);
            const float x = CAND(14, 0), y = CAND(15, 0);
            c[0] = fmax_(x, y); c[1] = fmin_(x, y);
#pragma unroll
            for (int i = 2; i < 16; ++i) c[i] = -3.0e38f;
            merge_top16(tc, c);
        }
#undef CAND
        float wgt[16]; float sum = 0.f;
#pragma unroll
        for (int i = 0; i < 16; ++i) { wgt[i] = __builtin_amdgcn_exp2f((tc[i] - tc[0]) * rsl); sum += wgt[i]; }
        const float inv = 1.0f / sum;
        int e[16];
#pragma unroll
        for (int i = 0; i < 16; ++i) { const unsigned bits = __builtin_bit_cast(unsigned, tc[i]); const unsigned ia = (bits >> 4) & 15u, ib = bits & 15u;
            e[i] = (int)(T1[ia * 64 + lane] * 128u + T2[ib * 64 + lane]); wgt[i] *= inv; }
        {
            const int tok = blk * 32 + r;
            GAS v4u* ep = (GAS v4u*)((unsigned short*)EIDX + (size_t)tok * 128 + head * 16); GAS f32x4* gp = (GAS f32x4*)(GATE + (size_t)tok * 128 + head * 16);
#pragma unroll
            for (int q = 0; q < 2; ++q) ep[q] = (v4u){(unsigned)e[8 * q] | ((unsigned)e[8 * q + 1] << 16), (unsigned)e[8 * q + 2] | ((unsigned)e[8 * q + 3] << 16),
                                                      (unsigned)e[8 * q + 4] | ((unsigned)e[8 * q + 5] << 16), (unsigned)e[8 * q + 6] | ((unsigned)e[8 * q + 7] << 16)};
#pragma unroll
            for (int q = 0; q < 4; ++q) gp[q] = (f32x4){wgt[4 * q], wgt[4 * q + 1], wgt[4 * q + 2], wgt[4 * q + 3]};
        }
    }
}

DI void unpack16(const v4u xa, const v4u xb, f32x2 (&h)[8]) {
    h[0] = (f32x2){bflo(xa[0]), bfhi(xa[0])}; h[1] = (f32x2){bflo(xa[1]), bfhi(xa[1])}; h[2] = (f32x2){bflo(xa[2]), bfhi(xa[2])}; h[3] = (f32x2){bflo(xa[3]), bfhi(xa[3])};
    h[4] = (f32x2){bflo(xb[0]), bfhi(xb[0])}; h[5] = (f32x2){bflo(xb[1]), bfhi(xb[1])}; h[6] = (f32x2){bflo(xb[2]), bfhi(xb[2])}; h[7] = (f32x2){bflo(xb[3]), bfhi(xb[3])};
}
DI float dot16_fp8(const f32x2 (&h)[8], const v4u r) {
    f32x2 acc = (f32x2){0.f, 0.f};
#pragma unroll
    for (int w = 0; w < 4; ++w) { const int rw = (int)r[w]; acc += h[2 * w] * __builtin_amdgcn_cvt_pk_f32_fp8(rw, false); acc += h[2 * w + 1] * __builtin_amdgcn_cvt_pk_f32_fp8(rw, true); }
    return acc.x + acc.y;
}
struct PeBuf { v4u row[16]; v4u xa, xb; };
DI void pe_ids(unsigned (&e)[8], const int* EIDX, int tok, int g) {
    const GAS v4u* p = (const GAS v4u*)((const unsigned short*)EIDX + (size_t)tok * 128 + 16 * g);
#pragma unroll
    for (int q = 0; q < 2; ++q) { const v4u w = p[q]; e[4 * q] = w[0]; e[4 * q + 1] = w[1]; e[4 * q + 2] = w[2]; e[4 * q + 3] = w[3]; }
}
#define PE_ID(e, i) (((i) & 1) ? ((e)[(i) >> 1] >> 16) : ((e)[(i) >> 1] & 0xffffu))
DI void peer_u_phase(const Args& a, const Ctx& F) {
    unsigned char* ws = a.ws;
    const bf16* X2 = (const bf16*)(ws + WS_S5); const int* EIDX = (const int*)(ws + WS_S0);
    const unsigned long long* SS2 = (const unsigned long long*)(ws + WS_SS2);
    const float* GATE = (const float*)(ws + WS_S0 + 16 * MiB); unsigned char* ACT = ws + WS_S0 + 32 * MiB;
    const int lane = F.lane, j = F.xj, g = lane >> 3, seg = lane & 7, r = lane & 15, kq = lane >> 4;
    const int wq = F.xrank * NWAVES + F.wave, NWQ = F.xn * NWAVES;
    const unsigned char* UB = (const unsigned char*)(ws + WS_UB);
    LAS unsigned char* img = F.lds + RING_OFF + F.wave * 16384;
    LAS unsigned char* xl = F.lds + LDSCTL_OFF + 1024 + F.wave * 256;
    LAS _Float16* zacc = (LAS _Float16*)(F.lds + ZACC_OFF + F.wave * 3584);
    unsigned wro[2];
#pragma unroll
    for (int b = 0; b < 2; ++b) { const int rr = 2 * g + b; wro[b] = (unsigned)(rr * 128 + ((seg ^ (rr & 7)) << 4)); }
    unsigned rdo[2];
#pragma unroll
    for (int s = 0; s < 2; ++s) rdo[s] = (unsigned)(r * 128 + (((4 * s + kq) ^ (r & 7)) << 4));
    constexpr int NCLS = T / 8;
    const int nk = wq < NCLS ? (NCLS - wq + NWQ - 1) / NWQ : 0;
    const int nit = 4 * nk;
    if (nit == 0) return;
    unsigned e[8]; v4u R[16]; v2u xw; v4u zx = (v4u){0u, 0u, 0u, 0u}, zy = zx;
#define PU_DECODE(it, tok_, sl_, s_, tb_) const int b_##tok_ = (it) >> 6, rem_##tok_ = (it) & 63, nb_##tok_ = (nk - 16 * b_##tok_) < 16 ? (nk - 16 * b_##tok_) : 16; \
        const int s_ = nb_##tok_ == 16 ? rem_##tok_ >> 4 : rem_##tok_ / nb_##tok_, tb_ = rem_##tok_ - s_ * nb_##tok_; \
        const int tok_ = 8 * (wq + (16 * b_##tok_ + tb_) * NWQ) + j, sl_ = (j + s_) & 3
#define PU_ISSUE(tok_, sl_) do { const unsigned char* US_ = UB + (size_t)(sl_) * NEXP * 128; _Pragma("unroll") for (int i = 0; i < 16; ++i) R[i] = *(const GAS v4u*)(US_ + (size_t)PE_ID(e, i) * 128 + 16 * seg); \
        xw = *(const GAS v2u*)(X2 + (size_t)(tok_) * D + 256 * (sl_) + 4 * lane); } while (0)
    { PU_DECODE(0, tk0, sl0, s0, tb0); pe_ids(e, EIDX, tk0, g); PU_ISSUE(tk0, sl0); }
    if (1 < nit) { PU_DECODE(1, tk1, sl1, s1, tb1); pe_ids(e, EIDX, tk1, g); }
    for (int it = 0; it < nit; ++it) {
        PU_DECODE(it, tok, sl, s, tb);
#pragma unroll
        for (int i = 0; i < 16; ++i) *(LAS v4u*)(img + (i & 7) * 2048 + wro[i >> 3]) = R[i];
        { int w = 0; const unsigned x0 = xw[0], x1 = xw[1];
          w = __builtin_amdgcn_cvt_pk_fp8_f32(bflo(x0), bfhi(x0), w, false); w = __builtin_amdgcn_cvt_pk_fp8_f32(bflo(x1), bfhi(x1), w, true); *(LAS unsigned*)(xl + 4 * lane) = (unsigned)w; }
        asm volatile("" ::: "memory");
        if (it + 1 < nit) { PU_DECODE(it + 1, tkn, sln, sn, tbn); PU_ISSUE(tkn, sln); }
        if (it + 2 < nit) { PU_DECODE(it + 2, tkm, slm, sm, tbm); pe_ids(e, EIDX, tkm, g); }
        __builtin_amdgcn_sched_barrier(0);
        i32x8 xb[2];
#pragma unroll
        for (int s2 = 0; s2 < 2; ++s2) { const i32x4 lo = *(const LAS i32x4*)(xl + 128 * s2 + 16 * kq), hi = *(const LAS i32x4*)(xl + 128 * s2 + 64 + 16 * kq); xb[s2] = __builtin_shufflevector(lo, hi, 0, 1, 2, 3, 4, 5, 6, 7); }
        float zr[8];
        i32x4 ar[4];
        ar[0] = *(const LAS i32x4*)(img + rdo[0]); ar[1] = *(const LAS i32x4*)(img + rdo[1]);
        __builtin_amdgcn_sched_group_barrier(0x100, 6, 0);
#pragma unroll
        for (int tl = 0; tl < 8; ++tl) {
            const i32x4 a0 = ar[(2 * tl) & 3], a1 = ar[(2 * tl + 1) & 3];
            if (tl + 1 < 8) { ar[(2 * tl + 2) & 3] = *(const LAS i32x4*)(img + (tl + 1) * 2048 + rdo[0]); ar[(2 * tl + 3) & 3] = *(const LAS i32x4*)(img + (tl + 1) * 2048 + rdo[1]); }
            pg8::f32x4 z = (pg8::f32x4){0.f, 0.f, 0.f, 0.f};
            z = __builtin_amdgcn_mfma_scale_f32_16x16x128_f8f6f4(__builtin_shufflevector(a0, a0, 0, 1, 2, 3, 4, 5, 6, 7), xb[0], z, 4  , 0  , 0, 0x7f7f7f7f, 0, 0x7f7f7f7f);
            z = __builtin_amdgcn_mfma_scale_f32_16x16x128_f8f6f4(__builtin_shufflevector(a1, a1, 0, 1, 2, 3, 4, 5, 6, 7), xb[1], z, 4  , 0  , 0, 0x7f7f7f7f, 0, 0x7f7f7f7f);
            __builtin_amdgcn_sched_group_barrier(0x100, 2, 0); __builtin_amdgcn_sched_group_barrier(0x8, 2, 0);
            const int n4 = r & 3;
            zr[tl] = n4 == 0 ? z[0] : n4 == 1 ? z[1] : n4 == 2 ? z[2] : z[3];
        }
        if (r < 4) { const int rr = 4 * kq + r, slot = 16 * (rr >> 1) + 8 * (rr & 1);
            LAS v4u* zp = (LAS v4u*)(zacc + (tb < 14 ? tb : 0) * 128 + slot);
            if (s > 0) { const v4u pw = tb < 14 ? zp[0] : tb == 14 ? zx : zy;
#pragma unroll
                for (int q = 0; q < 4; ++q) { const unsigned w = pw[q]; const h2_t hv = __builtin_bit_cast(h2_t, w); zr[2 * q] += (float)hv.x; zr[2 * q + 1] += (float)hv.y; } }
            if (s < 3) { v4u o;
#pragma unroll
                for (int q = 0; q < 4; ++q) { const h2_t hv = (h2_t){(_Float16)zr[2 * q], (_Float16)zr[2 * q + 1]}; o[q] = __builtin_bit_cast(unsigned, hv); }
                if (tb < 14) zp[0] = o; else if (tb == 14) zx = o; else zy = o; }
            else {
                const float rs = (1.0f / U_SCALE) / sqrtf(ss_get(SS2, tok) * (1.0f / D) + EPS);
                const GAS f32x4* gp = (const GAS f32x4*)(GATE + (size_t)tok * 128 + slot);
                const f32x4 g0 = gp[0], g1 = gp[1]; f32x4 o0, o1;
#pragma unroll
                for (int c = 0; c < 4; ++c) { const float v0 = zr[c] * rs, v1 = zr[4 + c] * rs;
                    o0[c] = 0.5f * v0 * (1.0f + erff(v0 * 0.70710678118654752f)) * g0[c]; o1[c] = 0.5f * v1 * (1.0f + erff(v1 * 0.70710678118654752f)) * g1[c]; }
                int w0 = 0, w1 = 0;
                w0 = __builtin_amdgcn_cvt_pk_fp8_f32(o0[0] * A_SCALE, o0[1] * A_SCALE, w0, false); w0 = __builtin_amdgcn_cvt_pk_fp8_f32(o0[2] * A_SCALE, o0[3] * A_SCALE, w0, true);
                w1 = __builtin_amdgcn_cvt_pk_fp8_f32(o1[0] * A_SCALE, o1[1] * A_SCALE, w1, false); w1 = __builtin_amdgcn_cvt_pk_fp8_f32(o1[2] * A_SCALE, o1[3] * A_SCALE, w1, true);
                *(GAS v2u*)(ACT + (size_t)tok * 128 + slot) = (v2u){(unsigned)w0, (unsigned)w1};
            }
        }
        asm volatile("" ::: "memory");
    }
#undef PU_ISSUE
#undef PU_DECODE
}
DI void peer_act_phase(const Args& a, const Ctx& F) {
    unsigned char* ws = a.ws;
    const unsigned long long* SS2 = (const unsigned long long*)(ws + WS_SS2); const GAS v2u* ZP = (const GAS v2u*)(ws + WS_S1);
    const GAS f32x4* GATE = (const GAS f32x4*)(ws + WS_S0 + 16 * MiB); GAS f32x4* ACT = (GAS f32x4*)(ws + WS_S0 + 32 * MiB);
    const int gt = F.vcu * (NWAVES * 64) + F.tid, NGT = F.G * NWAVES * 64;
    for (int i = gt; i < T * 32; i += NGT) {
        f32x4 z = (f32x4){0.f, 0.f, 0.f, 0.f};
#pragma unroll
        for (int l = 0; l < 4; ++l) { const v2u w = ZP[(size_t)l * T * 32 + i]; const unsigned w0 = w[0], w1 = w[1];
            const h2_t p0 = __builtin_bit_cast(h2_t, w0), p1 = __builtin_bit_cast(h2_t, w1);
            z += (f32x4){(float)p0.x, (float)p0.y, (float)p1.x, (float)p1.y}; }
        const float rs = (1.0f / U_SCALE) / sqrtf(ss_get(SS2, i >> 5) * (1.0f / D) + EPS);
        const f32x4 gte = GATE[i]; f32x4 o;
#pragma unroll
        for (int c = 0; c < 4; ++c) { const float v = z[c] * rs; o[c] = 0.5f * v * (1.0f + erff(v * 0.70710678118654752f)) * gte[c]; }
        ACT[i] = o;
    }
}
DI void peer_v_phase(const Args& a, const Ctx& F) {
    unsigned char* ws = a.ws;
    const bf16* X2 = (const bf16*)(ws + WS_S5); bf16* X3 = (bf16*)(ws + WS_S3);
    const int* EIDX = (const int*)(ws + WS_S0); const unsigned char* ACT = ws + WS_S0 + 32 * MiB;
    const int lane = F.lane, j = F.xj, g = lane >> 3, seg = lane & 7, r = lane & 15, kq = lane >> 4;
    const int wq = F.xrank * NWAVES + F.wave, NWQ = F.xn * NWAVES;
    const unsigned char* VB = (const unsigned char*)(ws + WS_VB);
    LAS unsigned char* img = F.lds + RING_OFF + F.wave * 16384;
    LAS unsigned char* al = F.lds + LDSCTL_OFF + 4096 + F.wave * 128;
    constexpr int NCLS = T / 8;
    const int nk = wq < NCLS ? (NCLS - wq + NWQ - 1) / NWQ : 0;
    const int nit = 4 * nk;
    if (nit == 0) return;
    const int coff = 16 * r + 4 * kq;
    f32x4 gq[4];
#pragma unroll
    for (int q = 0; q < 4; ++q) gq[q] = *(const f32x4*)(a.in[I_FING] + 256 * ((j + q) & 3) + coff);
    unsigned e[8]; v4u R[16]; v2u xw; unsigned short av; v2u xq[3] = {(v2u){0u, 0u}, (v2u){0u, 0u}, (v2u){0u, 0u}};
#define PV_DECODE(it, tok_, sl_, s_, tb_) const int b_##tok_ = (it) >> 6, rem_##tok_ = (it) & 63, nb_##tok_ = (nk - 16 * b_##tok_) < 16 ? (nk - 16 * b_##tok_) : 16; \
        const int s_ = nb_##tok_ == 16 ? rem_##tok_ >> 4 : rem_##tok_ / nb_##tok_, tb_ = rem_##tok_ - s_ * nb_##tok_; \
        const int tok_ = 8 * (wq + (16 * b_##tok_ + tb_) * NWQ) + j, sl_ = (j + s_) & 3
#define PV_ISSUE(t, sl_) do { const unsigned char* VS_ = VB + (size_t)(sl_) * NEXP * 128; _Pragma("unroll") for (int i = 0; i < 16; ++i) R[i] = *(const GAS v4u*)(VS_ + (size_t)PE_ID(e, i) * 128 + 16 * seg); \
        xw = *(const GAS v2u*)(X2 + (size_t)(t) * D + 256 * (sl_) + coff); av = *(const GAS unsigned short*)(ACT + (size_t)(t) * 128 + 2 * lane); } while (0)
    { PV_DECODE(0, tk0, sl0, s0, tb0); pe_ids(e, EIDX, tk0, g); PV_ISSUE(tk0, sl0); }
    if (1 < nit) { PV_DECODE(1, tk1, sl1, s1, tb1); pe_ids(e, EIDX, tk1, g); }
    for (int it = 0; it < nit; ++it) {
        PV_DECODE(it, tok, sl, s, tb);
#pragma unroll
        for (int i = 0; i < 16; ++i) *(LAS v4u*)(img + (16 * g + i) * 128 + ((seg ^ (i & 7)) << 4)) = R[i];
        *(LAS unsigned short*)(al + 2 * lane) = av;
        const v2u xcur = xw;
        asm volatile("" ::: "memory");
        if (it + 1 < nit) { PV_DECODE(it + 1, tkn, sln, sn, tbn); PV_ISSUE(tkn, sln); }
        if (it + 2 < nit) { PV_DECODE(it + 2, tkm, slm, sm, tbm); pe_ids(e, EIDX, tkm, g); }
        __builtin_amdgcn_sched_barrier(0);
        const i32x4 blo = *(const LAS i32x4*)(al + 16 * kq), bhi = *(const LAS i32x4*)(al + 64 + 16 * kq);
        const i32x8 bfrag = __builtin_shufflevector(blo, bhi, 0, 1, 2, 3, 4, 5, 6, 7);
        pg8::f32x4 mine = (pg8::f32x4){0.f, 0.f, 0.f, 0.f};
        const int s0_ = 32 * kq + r, s1_ = s0_ + 16;
#define VTR(slot_, ct_) __builtin_amdgcn_ds_read_tr4_b64_v2i32((LAS i32x2*)(img + (slot_) * 128 + (((((ct_) >> 1) ^ ((slot_) & 7))) << 4) + 8 * ((ct_) & 1)))
        i32x2 tr[4];
        tr[0] = VTR(s0_, 0); tr[1] = VTR(s1_, 0);
        __builtin_amdgcn_sched_group_barrier(0x100, 4, 0);
#pragma unroll
        for (int ct = 0; ct < 16; ++ct) {
            const i32x2 t0 = tr[(2 * ct) & 3], t1 = tr[(2 * ct + 1) & 3];
            if (ct + 1 < 16) { tr[(2 * ct + 2) & 3] = VTR(s0_, ct + 1); tr[(2 * ct + 3) & 3] = VTR(s1_, ct + 1); }
            const i32x4 a4 = (i32x4){t0[0], t0[1], t1[0], t1[1]};
            const pg8::f32x4 z = __builtin_amdgcn_mfma_scale_f32_16x16x128_f8f6f4(__builtin_shufflevector(a4, a4, 0, 1, 2, 3, 4, 5, 6, 7), bfrag, (pg8::f32x4){0.f, 0.f, 0.f, 0.f}, 4, 0, 0, 0x7f7f7f7f, 0, 0x7f7f7f7f);
            __builtin_amdgcn_sched_group_barrier(0x100, 2, 0); __builtin_amdgcn_sched_group_barrier(0x8, 1, 0);
            if (r == ct) mine = z;
        }
#undef VTR
        const float sc = 1.0f / (V_SCALE * A_SCALE);
        const float o0 = bflo(xcur[0]) + mine[0] * sc, o1 = bfhi(xcur[0]) + mine[1] * sc, o2 = bflo(xcur[1]) + mine[2] * sc, o3 = bfhi(xcur[1]) + mine[3] * sc;
        const v2u ocur = (v2u){pk2(o0, o1), pk2(o2, o3)};
        if (s < 3) *(GAS v2u*)(X3 + (size_t)tok * D + 256 * sl + coff) = ocur;
        else {
            f32x4 xv[4]; float ssq = 0.f;
#pragma unroll
            for (int q = 0; q < 4; ++q) { const v2u w = q < 3 ? xq[q] : ocur; const unsigned w0 = w[0], w1 = w[1]; xv[q] = (f32x4){bflo(w0), bfhi(w0), bflo(w1), bfhi(w1)};
                ssq += (xv[q][0] * xv[q][0] + xv[q][1] * xv[q][1]) + (xv[q][2] * xv[q][2] + xv[q][3] * xv[q][3]); }
            const float rn = 1.0f / sqrtf(wave_sum(ssq) * (1.0f / D) + EPS);
            float* orow = a.out + (size_t)tok * D + coff;
#pragma unroll
            for (int q = 0; q < 4; ++q) __builtin_nontemporal_store(xv[q] * gq[q] * rn, (GAS f32x4*)(orow + 256 * ((j + q) & 3)));
        }
        if (it + 1 < nit) { PV_DECODE(it + 1, tkr, slr, sr, tbr);
            if (sr == 3) {
#pragma unroll
                for (int q = 0; q < 3; ++q) xq[q] = *(const GAS v2u*)(X3 + (size_t)tkr * D + 256 * ((j + q) & 3) + coff); } }
        asm volatile("" ::: "memory");
    }
#undef PV_ISSUE
#undef PV_DECODE
}
DI void final_phase(const Args& a, const Ctx& F) {
    const float* gf = a.in[I_FING]; const bf16* X3 = (const bf16*)(a.ws + WS_S3);
    const int lane = F.lane, gw = F.vcu * NWAVES + F.wave, NGW = F.G * NWAVES;
    const f32x4 ga0 = *(const f32x4*)(gf + 8 * lane), ga1 = *(const f32x4*)(gf + 8 * lane + 4), gb0 = *(const f32x4*)(gf + 512 + 8 * lane), gb1 = *(const f32x4*)(gf + 512 + 8 * lane + 4);
    for (int tok = gw; tok < T; tok += NGW) {
        const v4u xa = __builtin_nontemporal_load((const GAS v4u*)(X3 + (size_t)tok * D + 8 * lane)), xb = __builtin_nontemporal_load((const GAS v4u*)(X3 + (size_t)tok * D + 512 + 8 * lane));
        A4 a0, a1, b0, b1; unpack8(xa, a0, a1); unpack8(xb, b0, b1);
        float s = (a0[0] * a0[0] + a0[1] * a0[1]) + (a0[2] * a0[2] + a0[3] * a0[3]) + (a1[0] * a1[0] + a1[1] * a1[1]) + (a1[2] * a1[2] + a1[3] * a1[3])
                + (b0[0] * b0[0] + b0[1] * b0[1]) + (b0[2] * b0[2] + b0[3] * b0[3]) + (b1[0] * b1[0] + b1[1] * b1[1]) + (b1[2] * b1[2] + b1[3] * b1[3]);
        const float rn = 1.0f / sqrtf(wave_sum(s) * (1.0f / D) + EPS);
        float* orow = a.out + (size_t)tok * D;
        __builtin_nontemporal_store(a0 * ga0 * rn, (GAS f32x4*)(orow + 8 * lane)); __builtin_nontemporal_store(a1 * ga1 * rn, (GAS f32x4*)(orow + 8 * lane + 4));
        __builtin_nontemporal_store(b0 * gb0 * rn, (GAS f32x4*)(orow + 512 + 8 * lane)); __builtin_nontemporal_store(b1 * gb1 * rn, (GAS f32x4*)(orow + 512 + 8 * lane + 4));
    }
}

__global__ void __launch_bounds__(NWAVES * 64, 2) fwd(Args args) {
    extern __shared__ __attribute__((aligned(16))) unsigned char lds[];
    Ctx F;
    F.lds = (LAS unsigned char*)lds;
    F.tid = threadIdx.x; F.lane = F.tid & 63; F.wave = __builtin_amdgcn_readfirstlane(F.tid >> 6);
    F.G = gridDim.x; { const int bx = blockIdx.x; F.vcu = (F.G % 8 == 0) ? (bx % 8) * (F.G / 8) + bx / 8 : bx; }
    volatile LAS unsigned* MISC = (volatile LAS unsigned*)(F.lds + MISC_OFF);
    unsigned char* ws = args.ws;
    gu32* ctl = (gu32*)(ws + WS_CTL);
    for (int u = F.tid; u < (LDS_BYTES - LDSCTL_OFF) / 4; u += NWAVES * 64) ((LAS unsigned*)(F.lds + LDSCTL_OFF))[u] = 0u;
    __syncthreads();
    XcdBarrier bar; bar.bar = (unsigned*)(ctl + CW_BAR); bar.x = 0; bar.st = nullptr; bar.wv = F.wave;
    if (N_LAUNCHES == 1) { bar = xcd_barrier_post((unsigned*)(ctl + CW_BAR), MISC + 8); bar.wv = F.wave; }
#if XCC_LABELS
    if (N_LAUNCHES == 1 && F.tid == 0) { const unsigned x = xb_xcc_id() & 7u; MISC[16] = x; MISC[17] = __hip_atomic_fetch_add(ctl + CW_XRANK + 64 * x, 1u, RLX_AGENT); }
    __syncthreads();
#endif
#define GRID_BAR() do { if (N_LAUNCHES == 1) xcd_barrier(bar); } while (0)
    const int lo = args.ph_lo, hi = args.ph_hi;
#ifndef PH_MASK
#define PH_MASK 0x7fff
#endif
#ifndef PH_REP
#define PH_REP 0x000
#endif
#define REPS(k) (1 + ((PH_REP >> (k)) & 1))
#define IN(k) (((PH_MASK >> (k)) & 1) && lo <= (k) && (k) < hi)
#define BOTH(k) (IN(k) && IN((k) + 1))
    LAS unsigned char* ring = F.lds + RING_OFF;
    const int bid = (int)blockIdx.x;

    if (IN(0)) { for (int rep = 0; rep < REPS(0); ++rep) p0_prologue(args, fresh(F)); if (BOTH(0)) GRID_BAR(); }

    if (IN(1)) { {
        { pg8::Gemm g{(const bf16*)(ws + WS_S0), (const bf16*)(ws + WS_WIN), T, 3072, D}; pg8::StaticOrder S; S.init(T, 3072, F.G, bid);
          EpiIn E{(const float*)(ws + WS_RS0), args.in[I_CFB1], ws, 0, 1.0f};
          pg8::gemm_phase<EpiIn, pg8::StaticOrder, PG8_ALIGN, PG8_SP2>(ring, g, S, E, F.wave); }
        { pg8::Gemm g{(const bf16*)(ws + WS_X8), (const bf16*)(ws + WS_WG8), T, 4096, D}; pg8::StaticOrder S; S.init(T, 4096, F.G, bid);
          EpiIn E{(const float*)(ws + WS_RS0), args.in[I_CFB1], ws, 12, 1.0f / WG_SCALE};
          pg8::gemm_phase<EpiIn, pg8::StaticOrder, PG8_ALIGN, PG8_SP2, true>(ring, g, S, E, F.wave); }
        kv_gemm(args, fresh(F)); }
        if (BOTH(1)) GRID_BAR();
    }

    if (IN(2)) { for (int rep = 0; rep < REPS(2); ++rep) conv_phase(args, fresh(F)); if (BOTH(2)) GRID_BAR(); }

    if (IN(3)) {
        pg8::Gemm g{(const bf16*)args.out, (const bf16*)(ws + WS_WSC), T, D, D}; pg8::StaticOrder S; S.init(T, D, F.G, bid);
        EpiMulGate E{(const bf16*)(ws + WS_S4), (bf16*)(ws + WS_S1)};
        pg8::gemm_phase<EpiMulGate, pg8::StaticOrder, PG8_ALIGN, PG8_SP2>(ring, g, S, E, F.wave);
    }
    if (IN(4)) {
        pg8::Gemm g{(const bf16*)(ws + WS_X8), (const bf16*)(ws + WS_WG8 + (size_t)6144 * D), T, D, D}; pg8::StaticOrder S; S.init(T, D, F.G, bid);
        EpiMerge E{(const bf16*)(ws + WS_S5), (const bf16*)(ws + WS_S1), args.in[I_BPW2], (bf16*)(ws + WS_S1), 1.0f / WG_SCALE};
        pg8::gemm_phase<EpiMerge, pg8::StaticOrder, PG8_ALIGN, PG8_SP2, true>(ring, g, S, E, F.wave);
        if (BOTH(4)) GRID_BAR();
    }
    if (IN(5)) {
        pg8::Gemm g{(const bf16*)(ws + WS_S1), (const bf16*)(ws + WS_WMIX), T, D, D}; pg8::StaticOrder S; S.init(T, D, F.G, bid);
        EpiResidN E{(const bf16*)(ws + WS_S0), (const float*)(ws + WS_RS0), (bf16*)(ws + WS_S2), (unsigned long long*)(ws + WS_SS1), ws + WS_X8, 1.0f};
        pg8::gemm_phase<EpiResidN, pg8::StaticOrder, PG8_ALIGN, PG8_SP2>(ring, g, S, E, F.wave);
        if (BOTH(5)) GRID_BAR();
    }
    if (IN(6)) {
        pg8::Gemm g{(const bf16*)(ws + WS_X8), (const bf16*)(ws + WS_WG8 + (size_t)4096 * D), T, D, D}; pg8::StaticOrder S; S.init(T, D, F.G, bid);
        EpiQFrag E{(const unsigned long long*)(ws + WS_SS1), (bf16*)(ws + WS_S3), 0.0625f * LOG2E / WG_SCALE};
        pg8::gemm_phase<EpiQFrag, pg8::StaticOrder, PG8_ALIGN, PG8_SP2, true>(ring, g, S, E, F.wave);
        if (BOTH(6) && N_LAUNCHES == 1) __builtin_amdgcn_fence(__ATOMIC_ACQUIRE, "agent");
    }
    if (IN(7)) { for (int rep = 0; rep < REPS(7); ++rep) attn_phase(args, fresh(F)); if (BOTH(7)) GRID_BAR(); }
    if (IN(8)) {
        pg8::Gemm g{(const bf16*)(ws + WS_S1), (const bf16*)(ws + WS_WG8 + (size_t)5120 * D), T, D, D}; pg8::StaticOrder S; S.init(T, D, F.G, bid);
        EpiResidN E{(const bf16*)(ws + WS_S2), nullptr, (bf16*)(ws + WS_S5), (unsigned long long*)(ws + WS_SS2), nullptr, 1.0f / WG_SCALE};
        pg8::gemm_phase<EpiResidN, pg8::StaticOrder, PG8_ALIGN, PG8_SP2, true>(ring, g, S, E, F.wave);
        if (BOTH(8)) GRID_BAR();
    }
    if (IN(9)) {
        pg8::Gemm g{(const bf16*)(ws + WS_S5), (const bf16*)(ws + WS_WPQ), T, 2048, D}; pg8::StaticOrder S; S.init(T, 2048, F.G, bid);
        EpiPQFrag E{(const unsigned long long*)(ws + WS_SS2), (bf16*)args.out};
        pg8::gemm_phase<EpiPQFrag, pg8::StaticOrder, PG8_ALIGN, PG8_SP2>(ring, g, S, E, F.wave);
        if (BOTH(9)) GRID_BAR();
    }
    if (IN(10)) { for (int rep = 0; rep < REPS(10); ++rep) route_phase(args, fresh(F)); if (BOTH(10)) GRID_BAR(); }
    if (IN(11) || IN(13)) {
        F.xj = bid & 7; F.xrank = bid >> 3; F.xn = (F.G - F.xj + 7) >> 3;
#if XCC_LABELS
        if (N_LAUNCHES == 1) {
            bool even = true;
#pragma unroll
            for (int q = 0; q < 8; ++q) even = even && (__hip_atomic_load(ctl + CW_XRANK + 64 * q, RLX_AGENT) == (unsigned)(F.G >> 3));
            if (even && (F.G & 7) == 0) { F.xj = (int)MISC[16]; F.xrank = (int)MISC[17]; F.xn = F.G >> 3; }
        }
#endif
    }
    if (IN(11)) { for (int rep = 0; rep < REPS(11); ++rep) peer_u_phase(args, fresh(F)); if (BOTH(11)) GRID_BAR(); }
    if (IN(13)) { for (int rep = 0; rep < REPS(13); ++rep) peer_v_phase(args, fresh(F)); }
#undef IN
#undef BOTH
}

extern "C" void kernel_launch(void* const* d_in, const int* in_sizes, int n_in, void* d_out, int out_size, void* d_ws, size_t ws_size, hipStream_t stream) {
    static int grid = 0;
    if (grid == 0) {
        if (n_in != 25 || in_sizes[0] != T * D || out_size != T * D || ws_size < WS_END) { fprintf(stderr, "kernel_launch: unexpected shapes (n_in %d, in0 %d, out %d, ws %zu)\n", n_in, n_in > 0 ? in_sizes[0] : -1, out_size, ws_size); grid = -1; return; }
        int dev = 0, cus = 0, per_cu = 0;
        if (hipGetDevice(&dev) != hipSuccess || hipDeviceGetAttribute(&cus, hipDeviceAttributeMultiprocessorCount, dev) != hipSuccess) { grid = -1; return; }
        if (hipFuncSetAttribute((const void*)fwd, hipFuncAttributeMaxDynamicSharedMemorySize, LDS_BYTES) != hipSuccess) { fprintf(stderr, "kernel_launch: hipFuncSetAttribute failed\n"); grid = -1; return; }
        if (hipOccupancyMaxActiveBlocksPerMultiprocessor(&per_cu, (const void*)fwd, NWAVES * 64, LDS_BYTES) != hipSuccess || per_cu < 1) { fprintf(stderr, "kernel_launch: occupancy query says %d blocks/CU\n", per_cu); }
        (void)hipGetLastError();
        grid = cus;
    }
    if (grid < 0) return;
    (void)hipMemsetAsync((char*)d_ws + WS_CTL, 0, CTL_ZERO_BYTES, stream);
    Args a{};
    for (int i = 0; i < 25; ++i) a.in[i] = (const float*)d_in[i];
    a.out = (float*)d_out; a.ws = (unsigned char*)d_ws;
    if (N_LAUNCHES == 1) { a.ph_lo = 0; a.ph_hi = NPH; a.li = 0; hipLaunchKernelGGL(fwd, dim3(grid), dim3(NWAVES * 64), LDS_BYTES, stream, a); }
    else for (int li = 0; li < NPH; ++li) { a.ph_lo = li; a.ph_hi = li + 1; a.li = li; hipLaunchKernelGGL(fwd, dim3(grid), dim3(NWAVES * 64), LDS_BYTES, stream, a); }
}
```
